# Optimizing an MI355X kernel written in HIP

```python
import jax, jax.numpy as jnp
from jax import lax
import numpy as np

D_MODEL = 1024
BATCH = 2
SEQ = 16384
DEPTH = 2
DEC_BATCH = 8
DEC_SEQ = 64
PAST_LEN = 4096

CHUNK = 64
GLA_HEADS = 4
GLA_DK = 64
GLA_DV = 128
GLA_GATE_RANK = 16
GLA_TAU = 16.0
GLA_W = GLA_HEADS * GLA_DV
GLA_KW = GLA_HEADS * GLA_DK
SB_HEADS = 4
SB_DH = 64
SB_W = SB_HEADS * SB_DH
SB_QBLOCK = 128
SB_KBLOCK = 128
CONV_CH = 256
CONV_W = 3
MIX_W = GLA_W + SB_W + CONV_CH
D_FF = 4 * D_MODEL
LN_EPS = 1e-5
DEEPNORM_ALPHA = (2 * DEPTH) ** 0.25
DEEPNORM_BETA = (8 * DEPTH) ** -0.25
SPLITS = (GLA_KW, GLA_KW, GLA_W, GLA_W, GLA_GATE_RANK, SB_W, SB_W, SB_W, CONV_CH, CONV_CH, CONV_CH)
N_IN = GLA_KW * 2 + GLA_W * 2 + GLA_GATE_RANK + SB_W * 3 + CONV_CH * 3

kernel_name = "hymba_gla_stickbreak_shortconv_deepnorm_step"


def layer_norm(x, g, b):
    xf = x.astype(jnp.float32)
    mu = xf.mean(-1, keepdims=True)
    var = jnp.square(xf - mu).mean(-1, keepdims=True)
    return ((xf - mu) * lax.rsqrt(var + LN_EPS) * g + b).astype(x.dtype)


def split_cols(z):
    outs, idx = [], 0
    for n in SPLITS:
        outs.append(z[..., idx:idx + n])
        idx += n
    return outs


def gla_chunk(S, q, k, v, lg):
    C = q.shape[2]
    b = jnp.cumsum(lg, axis=2)
    causal = jnp.tril(jnp.ones((C, C), dtype=bool))
    diff = b[:, :, :, None, :] - b[:, :, None, :, :]
    decay = jnp.exp(jnp.where(causal[None, None, :, :, None], diff, -jnp.inf))
    att = jnp.einsum('bhtk,bhsk,bhtsk->bhts', q, k, decay)
    o = (jnp.einsum('bhtk,bhkv->bhtv', q * jnp.exp(b), S)
         + jnp.einsum('bhts,bhsv->bhtv', att, v))
    b_last = b[:, :, -1:, :]
    S_new = (jnp.exp(b_last[:, :, 0, :])[..., None] * S
             + jnp.einsum('bhsk,bhsv->bhkv', k * jnp.exp(b_last - b), v))
    return S_new, o


def gla_seq(S0, q, k, v, lg):
    B, T = q.shape[0], q.shape[1]
    C = min(CHUNK, T)
    n = T // C

    def to_blocks(a):
        return a.reshape(B, n, C, a.shape[2], a.shape[3]).transpose(1, 0, 3, 2, 4)

    S_fin, o = lax.scan(lambda S, xs: gla_chunk(S, *xs), S0,
                        (to_blocks(q), to_blocks(k), to_blocks(v), to_blocks(lg)))
    o = o.transpose(1, 0, 3, 2, 4).reshape(B, T, GLA_HEADS, GLA_DV)
    return S_fin, o


def sb_block(q, q_pos, k, v):
    B, Qb, K = q.shape[0], q.shape[1], k.shape[1]
    nb = K // SB_KBLOCK
    k_pos = jnp.arange(K, dtype=jnp.int32)
    z = jnp.einsum('bqhd,bkhd->bhqk', q, k).astype(jnp.float32) * (SB_DH ** -0.5)
    mask = k_pos[None, :] < q_pos[:, None]
    lk = jnp.where(mask, jax.nn.log_sigmoid(-z), 0.0)
    lkb = lk.reshape(B, SB_HEADS, Qb, nb, SB_KBLOCK)
    later = (jnp.arange(SB_KBLOCK)[:, None] > jnp.arange(SB_KBLOCK)[None, :]).astype(jnp.float32)
    after_in = jnp.einsum('bhqnj,js->bhqns', lkb, later, precision=lax.Precision.HIGHEST)
    bsum = lkb.sum(-1)
    suff = bsum.sum(-1, keepdims=True) - jnp.cumsum(bsum, axis=-1)
    after = (after_in + suff[..., None]).reshape(B, SB_HEADS, Qb, K)
    A = jnp.exp(jnp.where(mask, jax.nn.log_sigmoid(z) + after, -jnp.inf))
    return jnp.einsum('bhqk,bkhd->bqhd', A.astype(v.dtype), v)


def sb_attention(q, k, v, past_len):
    B, T = q.shape[0], q.shape[1]
    Qb = min(SB_QBLOCK, T)
    n = T // Qb
    outs = []
    for i in range(n):
        q_pos = past_len + i * Qb + jnp.arange(Qb, dtype=jnp.int32)
        kend = past_len + (i + 1) * Qb
        kpad = -(-kend // SB_KBLOCK) * SB_KBLOCK
        kk, vv = k[:, :kend], v[:, :kend]
        if kpad > kend:
            padw = ((0, 0), (0, kpad - kend), (0, 0), (0, 0))
            kk, vv = jnp.pad(kk, padw), jnp.pad(vv, padw)
        outs.append(sb_block(q[:, i * Qb:(i + 1) * Qb], q_pos, kk, vv))
    return jnp.concatenate(outs, axis=1).reshape(B, T, SB_W)


def short_conv(u, prev, w):
    T = u.shape[1]
    up = jnp.concatenate([prev.astype(u.dtype), u], axis=1)
    y = w[CONV_W - 1] * up[:, CONV_W - 1:CONV_W - 1 + T]
    for i in range(CONV_W - 1):
        y = y + w[i] * up[:, i:i + T]
    return y, up[:, -(CONV_W - 1):]


def token_mixer(x, w_in, w_gate_up, b_gate, gla_norm_g, conv_w, w_out,
                past_k, past_v, S0, conv_prev, past_len):
    B, T, _ = x.shape
    f32 = jnp.float32
    gq, gk, gv, gr, glow, sq, sk, sv, cb, cc, ch = split_cols(x @ w_in)

    def heads(a, h):
        return a.reshape(B, T, h, -1)

    lg = jax.nn.log_sigmoid((glow @ w_gate_up + b_gate).astype(f32)) / GLA_TAU
    S_fin, go = gla_seq(S0.astype(f32),
                        heads(gq, GLA_HEADS).astype(f32) * (GLA_DK ** -0.5),
                        heads(gk, GLA_HEADS).astype(f32),
                        heads(gv, GLA_HEADS).astype(f32),
                        heads(lg, GLA_HEADS))
    go = go * lax.rsqrt(jnp.mean(go * go, axis=-1, keepdims=True) + LN_EPS)
    go = go.reshape(B, T, GLA_W).astype(x.dtype) * gla_norm_g * jax.nn.silu(gr)

    k_new, v_new = heads(sk, SB_HEADS), heads(sv, SB_HEADS)
    if past_k is None:
        k_all, v_all = k_new, v_new
    else:
        k_all = jnp.concatenate([past_k.astype(k_new.dtype), k_new], axis=1)
        v_all = jnp.concatenate([past_v.astype(v_new.dtype), v_new], axis=1)
    so = sb_attention(heads(sq, SB_HEADS), k_all, v_all, past_len)

    cy, conv_state = short_conv(cc * ch, conv_prev, conv_w)
    co = cb * cy

    out = jnp.concatenate([go, so, co], axis=-1) @ w_out
    return out, k_new, v_new, S_fin.astype(x.dtype), conv_state


def setup_inputs(seed: int = 0) -> dict:
    key = jax.random.key(seed)
    ks = jax.random.split(key, 24)

    def nrm(k, shape, s=1.0):
        return jax.random.normal(k, shape, jnp.float32) * s

    return {
        "x_prompt": nrm(ks[0], (BATCH, SEQ, D_MODEL)),
        "x_sample": nrm(ks[1], (DEC_BATCH, DEC_SEQ, D_MODEL)),
        "cache_sb_k": nrm(ks[2], (DEPTH, DEC_BATCH, PAST_LEN, SB_HEADS, SB_DH)),
        "cache_sb_v": nrm(ks[3], (DEPTH, DEC_BATCH, PAST_LEN, SB_HEADS, SB_DH)),
        "state_gla": nrm(ks[4], (DEPTH, DEC_BATCH, GLA_HEADS, GLA_DK, GLA_DV), 2.0),
        "state_conv": nrm(ks[5], (DEPTH, DEC_BATCH, CONV_W - 1, CONV_CH)),
        "ln_in_g": 1.0 + nrm(ks[6], (D_MODEL,), 0.02),
        "ln_in_b": nrm(ks[7], (D_MODEL,), 0.02),
        "w_in": nrm(ks[8], (DEPTH, D_MODEL, N_IN), D_MODEL ** -0.5),
        "w_gate_up": nrm(ks[9], (DEPTH, GLA_GATE_RANK, GLA_KW), GLA_GATE_RANK ** -0.5),
        "b_gate": nrm(ks[10], (DEPTH, GLA_KW), 0.02),
        "gla_norm_g": 1.0 + nrm(ks[11], (DEPTH, GLA_W), 0.02),
        "conv_w": nrm(ks[12], (DEPTH, CONV_W, CONV_CH), CONV_W ** -0.5),
        "w_out": nrm(ks[13], (DEPTH, MIX_W, D_MODEL), MIX_W ** -0.5 * DEEPNORM_BETA),
        "ln1_g": 1.0 + nrm(ks[14], (DEPTH, D_MODEL), 0.02),
        "ln1_b": nrm(ks[15], (DEPTH, D_MODEL), 0.02),
        "w_up": nrm(ks[16], (DEPTH, D_MODEL, D_FF), D_MODEL ** -0.5),
        "w_down": nrm(ks[17], (DEPTH, D_FF, D_MODEL), D_FF ** -0.5 * DEEPNORM_BETA),
        "ln2_g": 1.0 + nrm(ks[18], (DEPTH, D_MODEL), 0.02),
        "ln2_b": nrm(ks[19], (DEPTH, D_MODEL), 0.02),
    }


def reference(x_prompt, x_sample, cache_sb_k, cache_sb_v, state_gla, state_conv,
              ln_in_g, ln_in_b, w_in, w_gate_up, b_gate, gla_norm_g, conv_w, w_out,
              ln1_g, ln1_b, w_up, w_down, ln2_g, ln2_b):

    def trunk(x, c_k, c_v, s_gla, s_conv):
        B = x.shape[0]
        past_len = 0 if c_k is None else c_k.shape[2]
        x = layer_norm(x, ln_in_g, ln_in_b)
        ks_, vs_, gs_, cs_ = [], [], [], []
        for l in range(DEPTH):
            if c_k is None:
                pk, pv = None, None
                S0 = jnp.zeros((B, GLA_HEADS, GLA_DK, GLA_DV), jnp.float32)
                cprev = jnp.zeros((B, CONV_W - 1, CONV_CH), x.dtype)
            else:
                pk, pv, S0, cprev = c_k[l], c_v[l], s_gla[l], s_conv[l]
            mix, kn, vn, Sf, cst = token_mixer(x, w_in[l], w_gate_up[l], b_gate[l], gla_norm_g[l],
                                               conv_w[l], w_out[l], pk, pv, S0, cprev, past_len)
            x = layer_norm(DEEPNORM_ALPHA * x + mix, ln1_g[l], ln1_b[l])
            ff = jnp.square(jax.nn.relu(x @ w_up[l])) @ w_down[l]
            x = layer_norm(DEEPNORM_ALPHA * x + ff, ln2_g[l], ln2_b[l])
            ks_.append(kn); vs_.append(vn); gs_.append(Sf); cs_.append(cst)
        return x, jnp.stack(ks_), jnp.stack(vs_), jnp.stack(gs_), jnp.stack(cs_)

    y_prompt, k_p, v_p, gla_p, conv_p = trunk(x_prompt, None, None, None, None)
    y_sample, k_s, v_s, gla_s, conv_s = trunk(x_sample, cache_sb_k, cache_sb_v, state_gla, state_conv)
    return (y_prompt, y_sample, k_p, v_p, gla_p, conv_p, k_s, v_s, gla_s, conv_s)
```

```cpp
#include <hip/hip_runtime.h>
#include <hip/hip_cooperative_groups.h>
#include <cstdio>
#include <cstdint>
namespace cg = cooperative_groups;
namespace pg8 {
#define PG8_LAS __attribute__((address_space(3)))
typedef unsigned short bf16_t;
typedef short bf16x8 __attribute__((ext_vector_type(8)));
typedef float f32x4 __attribute__((ext_vector_type(4)));
typedef unsigned u32x4 __attribute__((ext_vector_type(4)));
constexpr int BM = 256, BK = 64, HALF = 128, HTB = HALF * BK * 2  , STAGE_BYTES = 8 * HTB, NXCD = 8, WGM = 8;

__host__ __device__ __forceinline__ int lds_byte(int r, int c) { const int st = (r >> 4) * 2 + (c >> 5), rr = r & 15, cc = c & 31, ob = rr * 64 + cc * 2; return st * 1024 + (ob ^ (((ob >> 9) & 1) << 5)); }
__host__ __device__ __forceinline__ void stage_rc(int b, int& R, int& C) { const int st = b / 1024, sb = b % 1024, swz = sb ^ (((sb >> 9) & 1) << 5); R = (st >> 1) * 16 + swz / 64; C = (st & 1) * 32 + (swz % 64) / 2; }
__host__ __device__ __forceinline__ int perm32(int rho) { const int n = rho >> 4, i = rho & 15; return 8 * (i >> 2) + 4 * n + (i & 3); }

struct Unit { int pm, pn; };
struct Gemm { const bf16_t* A; const bf16_t* Bt; int M, N, K; };

struct StaticOrder {
    int nM, nN, nwg, G, c;
    __host__ __device__ void init(int M, int N, int G_, int c_) { nM = M / BM; nN = N / BM; nwg = nM * nN; G = G_; c = c_; }
    __host__ __device__ bool next(int i, Unit& u) const {
        const long L = (long)i * G + c; if (L >= nwg) return false;
        int wgid = (int)L; { const int q = nwg / NXCD, r = nwg % NXCD, xcd = wgid % NXCD, off = wgid / NXCD; wgid = (xcd < r ? xcd * (q + 1) : r * (q + 1) + (xcd - r) * q) + off; }
        const int nig = WGM * nN, gid = wgid / nig, fm = gid * WGM, gsz = (nM - fm) < WGM ? (nM - fm) : WGM;
        u.pm = fm + ((wgid % nig) % gsz); u.pn = (wgid % nig) / gsz; return true;
    }
    __device__ __forceinline__ void a_ready(const Unit&) const {}
    __device__ __forceinline__ void done(const Unit&) const {}
};

__device__ __forceinline__ unsigned cvt_pk_bf16(float lo, float hi) { unsigned r; asm volatile("v_cvt_pk_bf16_f32 %0, %1, %2" : "=v"(r) : "v"(lo), "v"(hi)); return r; }
typedef unsigned u32x4 __attribute__((ext_vector_type(4)));
__device__ __forceinline__ float bf_lo(unsigned w) { return __builtin_bit_cast(float, w << 16); }
__device__ __forceinline__ float bf_hi(unsigned w) { return __builtin_bit_cast(float, w & 0xffff0000u); }

struct EpiZ {
    static constexpr bool PERM = true, AFTER_DRAIN = false;
    bf16_t* Zp; float* out; int l;
    __device__ __forceinline__ void operator()(const f32x4 (&acc)[2][2][4][2], const Unit& u, int wr, int wc, int fr, int fq) const {
        constexpr int ldz = 3328; constexpr size_t O_KP = 34078720, O_VP = 50855936, O_KS = 67766272, O_VS = 68028416;
        const int row0 = u.pm * BM + wr * 64 + fr, colt = wc * 32 + 8 * fq, col0 = u.pn * BM + colt;
        const bool smp = u.pm >= 128; const bool kvt = (u.pn == 7) || (u.pn == 8);
        const size_t fbase = smp ? ((u.pn == 7 ? O_KS : O_VS) + (size_t)l * 131072) : ((u.pn == 7 ? O_KP : O_VP) + (size_t)l * 8388608);
        float* fo = out + fbase + (size_t)(row0 - (smp ? 32768 : 0)) * 256 + colt;
#pragma unroll
        for (int ai = 0; ai < 2; ++ai)
#pragma unroll
            for (int m = 0; m < 4; ++m) { const int ro = ai * HALF + m * 16; bf16_t* rowp = Zp + (size_t)(row0 + ro) * ldz + col0;
#pragma unroll
                for (int bj = 0; bj < 2; ++bj) { const f32x4 v0 = acc[ai][bj][m][0], v1 = acc[ai][bj][m][1];
                    u32x4 w; w.x = cvt_pk_bf16(v0[0], v0[1]); w.y = cvt_pk_bf16(v0[2], v0[3]); w.z = cvt_pk_bf16(v1[0], v1[1]); w.w = cvt_pk_bf16(v1[2], v1[3]);
                    *(u32x4*)(rowp + bj * HALF) = w;
                    if (kvt) { float* p = fo + (size_t)ro * 256 + bj * HALF; *(f32x4*)p = v0; *(f32x4*)(p + 4) = v1; } }
                asm volatile("" ::: "memory"); }
    }
};
struct EpiT {
    static constexpr bool PERM = true, AFTER_DRAIN = false;
    const bf16_t* X; float* T;
    __device__ __forceinline__ void operator()(const f32x4 (&acc)[2][2][4][2], const Unit& u, int wr, int wc, int fr, int fq) const {
        constexpr float alpha = 1.41421356237309515f;
        const int row0 = u.pm * BM + wr * 64 + fr, col0 = u.pn * BM + wc * 32 + 8 * fq;
#pragma unroll
        for (int ai = 0; ai < 2; ++ai)
#pragma unroll
            for (int m = 0; m < 4; ++m) { const size_t off = (size_t)(row0 + ai * HALF + m * 16) * 1024 + col0;
#pragma unroll
                for (int bj = 0; bj < 2; ++bj) { const u32x4 xw = *(const u32x4*)(X + off + bj * HALF);
                    f32x4 v0 = acc[ai][bj][m][0], v1 = acc[ai][bj][m][1];
                    v0[0] += alpha * bf_lo(xw.x); v0[1] += alpha * bf_hi(xw.x); v0[2] += alpha * bf_lo(xw.y); v0[3] += alpha * bf_hi(xw.y);
                    v1[0] += alpha * bf_lo(xw.z); v1[1] += alpha * bf_hi(xw.z); v1[2] += alpha * bf_lo(xw.w); v1[3] += alpha * bf_hi(xw.w);
                    float* p = T + off + bj * HALF; *(f32x4*)p = v0; *(f32x4*)(p + 4) = v1; }
                asm volatile("" ::: "memory"); }
    }
};
struct EpiH {
    static constexpr bool PERM = true, AFTER_DRAIN = false;
    bf16_t* Hp;
    __device__ __forceinline__ void operator()(const f32x4 (&acc)[2][2][4][2], const Unit& u, int wr, int wc, int fr, int fq) const {
        constexpr int ldh = 4096; const int row0 = u.pm * BM + wr * 64 + fr, col0 = u.pn * BM + wc * 32 + 8 * fq;
#pragma unroll
        for (int ai = 0; ai < 2; ++ai)
#pragma unroll
            for (int m = 0; m < 4; ++m) { bf16_t* rowp = Hp + (size_t)(row0 + ai * HALF + m * 16) * ldh + col0;
#pragma unroll
                for (int bj = 0; bj < 2; ++bj) { f32x4 v0 = acc[ai][bj][m][0], v1 = acc[ai][bj][m][1];
#pragma unroll
                    for (int e = 0; e < 4; ++e) { const float a = v0[e] > 0.f ? v0[e] : 0.f, b = v1[e] > 0.f ? v1[e] : 0.f; v0[e] = a * a; v1[e] = b * b; }
                    u32x4 w; w.x = cvt_pk_bf16(v0[0], v0[1]); w.y = cvt_pk_bf16(v0[2], v0[3]); w.z = cvt_pk_bf16(v1[0], v1[1]); w.w = cvt_pk_bf16(v1[2], v1[3]);
                    *(u32x4*)(rowp + bj * HALF) = w; }
                asm volatile("" ::: "memory"); }
    }
};
template <class Epi, class Sched, bool ALIGN_EPI = false, bool SP2 = false>
__device__ __forceinline__ void gemm_phase(PG8_LAS unsigned char* lds, const Gemm g, const Sched& S, const Epi& E) {
    int tid_ = threadIdx.x; asm volatile("" : "+v"(tid_));
    const int tid = tid_, wid = __builtin_amdgcn_readfirstlane(tid >> 6), lane = tid & 63, wr = wid >> 2, wc = wid & 3, fr = lane & 15, fq = lane >> 4;
    const int K = g.K, nt = K / BK;
    unsigned voffA[2], voffB[2];
#pragma unroll
    for (int i = 0; i < 2; ++i) { int R, C; stage_rc(tid * 16 + i * 8192, R, C); const int Rb = Epi::PERM ? ((R & ~31) + perm32(R & 31)) : R;
        voffA[i] = (unsigned)(R * K + C) * 2u; voffB[i] = (unsigned)(Rb * K + C) * 2u; }
    const size_t kstep = (size_t)(BK * 2);
    const size_t hstep = (size_t)HALF * K * 2;
    const size_t tstep = 2 * hstep;
    const unsigned ldsw = (unsigned)wid * 1024u;
    const int aoff = lds_byte(wr * 64 + fr, fq * 8), boff = lds_byte(wc * 32 + fr, fq * 8);
#define PG8_SA(b, h) (((b) * 2 + (h)) * HTB)
#define PG8_SB(b, h) ((4 + (b) * 2 + (h)) * HTB)
#define PG8_STAGE(bufoff, gbase, voff) do { _Pragma("unroll") for (int _i = 0; _i < 2; ++_i) \
        __builtin_amdgcn_global_load_lds((const unsigned*)((const char*)(gbase) + (voff)[_i]), (PG8_LAS unsigned*)(lds + (bufoff) + ldsw + _i * 8192), 16, 0, 0); } while (0)
#define PG8_LDA(dst, b, h) do { _Pragma("unroll") for (int m = 0; m < 4; ++m) _Pragma("unroll") for (int k = 0; k < 2; ++k) dst[m][k] = *(const PG8_LAS bf16x8*)(lds + PG8_SA(b, h) + aoff + m * 2048 + k * 1024); } while (0)
#define PG8_LDB(dst, b, h) do { _Pragma("unroll") for (int n = 0; n < 2; ++n) _Pragma("unroll") for (int k = 0; k < 2; ++k) dst[n][k] = *(const PG8_LAS bf16x8*)(lds + PG8_SB(b, h) + boff + n * 2048 + k * 1024); } while (0)
#define PG8_MMA(ai, bj, At, Bt) do { __builtin_amdgcn_s_setprio(1); _Pragma("unroll") for (int m = 0; m < 4; ++m) _Pragma("unroll") for (int n = 0; n < 2; ++n) _Pragma("unroll") for (int k = 0; k < 2; ++k) \
        acc[ai][bj][m][n] = __builtin_amdgcn_mfma_f32_16x16x32_bf16(Bt[n][k], At[m][k], acc[ai][bj][m][n], 0, 0, 0); __builtin_amdgcn_s_setprio(0); } while (0)
#define PG8_WAIT_V(n) asm volatile("s_waitcnt vmcnt(" #n ")" ::: "memory")
#define PG8_WAIT_L(n) asm volatile("s_waitcnt lgkmcnt(" #n ")" ::: "memory")
#define PG8_BAR __builtin_amdgcn_s_barrier()
#define PG8_SCHED __builtin_amdgcn_sched_barrier(0)
    Unit cur, nxt; int ui = 0;
    if (!S.next(0, cur)) return;
    f32x4 acc[2][2][4][2];
#pragma unroll
    for (int a = 0; a < 2; ++a)
#pragma unroll
        for (int b = 0; b < 2; ++b)
#pragma unroll
            for (int m = 0; m < 4; ++m)
#pragma unroll
                for (int n = 0; n < 2; ++n) acc[a][b][m][n] = (f32x4){0.f, 0.f, 0.f, 0.f};
    bf16x8 At[4][2], B0[2][2], B1[2][2];
    const char* cA = (const char*)g.A + (size_t)cur.pm * tstep; const char* cB = (const char*)g.Bt + (size_t)cur.pn * tstep;
    S.a_ready(cur);
    if constexpr (SP2) {
        PG8_STAGE(PG8_SB(0, 0), cB, voffB); PG8_STAGE(PG8_SB(0, 1), cB + hstep, voffB); PG8_STAGE(PG8_SA(0, 0), cA, voffA); PG8_STAGE(PG8_SA(0, 1), cA + hstep, voffA);
        if (wr == 1) PG8_BAR;
        PG8_WAIT_V(2); PG8_BAR;
        PG8_STAGE(PG8_SB(1, 0), cB + kstep, voffB); PG8_STAGE(PG8_SA(1, 0), cA + kstep, voffA); PG8_STAGE(PG8_SB(1, 1), cB + hstep + kstep, voffB);
        PG8_WAIT_V(6); PG8_BAR;
    } else {
        PG8_STAGE(PG8_SB(0, 0), cB, voffB); PG8_STAGE(PG8_SA(0, 0), cA, voffA); PG8_STAGE(PG8_SB(0, 1), cB + hstep, voffB); PG8_STAGE(PG8_SA(0, 1), cA + hstep, voffA);
        if (wr == 1) PG8_BAR;
        PG8_WAIT_V(4); PG8_BAR;
        PG8_STAGE(PG8_SB(1, 0), cB + kstep, voffB); PG8_STAGE(PG8_SA(1, 0), cA + kstep, voffA); PG8_STAGE(PG8_SB(1, 1), cB + hstep + kstep, voffB);
        PG8_WAIT_V(6); PG8_BAR;
    }
    for (;;) {
        const bool has_next = S.next(ui + 1, nxt);
        const char* nA = has_next ? (const char*)g.A + (size_t)nxt.pm * tstep : cA; const char* nB = has_next ? (const char*)g.Bt + (size_t)nxt.pn * tstep : cB;
        for (int t = 0; t < nt; t += 2) {
            const bool last = (t == nt - 2);
            const char* a1 = cA + (size_t)(t + 1) * kstep;
            const char* a2 = last ? nA : cA + (size_t)(t + 2) * kstep; const char* b2 = last ? nB : cB + (size_t)(t + 2) * kstep;
            const char* a3 = a2 + kstep; const char* b3 = b2 + kstep;
            if (last && has_next) S.a_ready(nxt);
            if constexpr (SP2) {
            PG8_LDB(B0, 0, 0); PG8_LDB(B1, 0, 1); PG8_SCHED; PG8_LDA(At, 0, 0); PG8_STAGE(PG8_SA(1, 1), a1 + hstep, voffA);
            PG8_WAIT_V(8); PG8_WAIT_L(0); PG8_BAR; PG8_MMA(0, 0, At, B0); PG8_MMA(0, 1, At, B1); PG8_BAR; PG8_SCHED;
            PG8_LDA(At, 0, 1); PG8_STAGE(PG8_SB(0, 0), b2, voffB); PG8_STAGE(PG8_SB(0, 1), b2 + hstep, voffB); PG8_STAGE(PG8_SA(0, 0), a2, voffA);
            PG8_WAIT_V(8); PG8_WAIT_L(0); PG8_BAR; PG8_MMA(1, 0, At, B0); PG8_MMA(1, 1, At, B1); PG8_BAR; PG8_SCHED;
            PG8_LDB(B0, 1, 0); PG8_LDB(B1, 1, 1); PG8_SCHED; PG8_LDA(At, 1, 0); PG8_STAGE(PG8_SA(0, 1), a2 + hstep, voffA);
            PG8_WAIT_V(8); PG8_WAIT_L(0); PG8_BAR; PG8_MMA(0, 0, At, B0); PG8_MMA(0, 1, At, B1); PG8_BAR; PG8_SCHED;
            PG8_LDA(At, 1, 1); PG8_STAGE(PG8_SB(1, 0), b3, voffB); PG8_STAGE(PG8_SB(1, 1), b3 + hstep, voffB); PG8_STAGE(PG8_SA(1, 0), a3, voffA);
            PG8_WAIT_V(8); PG8_WAIT_L(0); PG8_BAR; PG8_MMA(1, 0, At, B0); PG8_MMA(1, 1, At, B1); PG8_BAR; PG8_SCHED;
            } else {
            PG8_LDB(B0, 0, 0); PG8_SCHED; PG8_LDA(At, 0, 0); PG8_STAGE(PG8_SA(1, 1), a1 + hstep, voffA);
            PG8_WAIT_L(8); PG8_BAR; PG8_WAIT_L(0); PG8_MMA(0, 0, At, B0); PG8_BAR; PG8_SCHED;
            PG8_LDB(B1, 0, 1); PG8_STAGE(PG8_SB(0, 0), b2, voffB);
            PG8_BAR; PG8_WAIT_L(0); PG8_MMA(0, 1, At, B1); PG8_BAR;
            PG8_LDA(At, 0, 1); PG8_STAGE(PG8_SA(0, 0), a2, voffA);
            PG8_BAR; PG8_WAIT_L(0); PG8_MMA(1, 0, At, B0); PG8_BAR; PG8_SCHED;
            PG8_STAGE(PG8_SB(0, 1), b2 + hstep, voffB);
            PG8_WAIT_V(6); PG8_BAR; PG8_MMA(1, 1, At, B1); PG8_BAR;
            PG8_LDB(B0, 1, 0); PG8_SCHED; PG8_LDA(At, 1, 0); PG8_STAGE(PG8_SA(0, 1), a2 + hstep, voffA);
            PG8_WAIT_L(8); PG8_BAR; PG8_WAIT_L(0); PG8_MMA(0, 0, At, B0); PG8_BAR; PG8_SCHED;
            PG8_LDB(B1, 1, 1); PG8_STAGE(PG8_SB(1, 0), b3, voffB);
            PG8_BAR; PG8_WAIT_L(0); PG8_MMA(0, 1, At, B1); PG8_BAR;
            PG8_LDA(At, 1, 1); PG8_STAGE(PG8_SA(1, 0), a3, voffA);
            PG8_BAR; PG8_WAIT_L(0); PG8_MMA(1, 0, At, B0); PG8_BAR; PG8_SCHED;
            PG8_STAGE(PG8_SB(1, 1), b3 + hstep, voffB);
            PG8_WAIT_V(6); PG8_BAR; PG8_MMA(1, 1, At, B1); PG8_BAR;
            }
        }
        if constexpr (ALIGN_EPI) { if (wr == 0) PG8_BAR; }
        if constexpr (!Epi::AFTER_DRAIN) { E(acc, cur, wr, wc, fr, fq); S.done(cur); }
        if (!has_next) break;
#pragma unroll
        for (int a = 0; a < 2; ++a)
#pragma unroll
            for (int b = 0; b < 2; ++b)
#pragma unroll
                for (int m = 0; m < 4; ++m)
#pragma unroll
                    for (int n = 0; n < 2; ++n) acc[a][b][m][n] = (f32x4){0.f, 0.f, 0.f, 0.f};
        cur = nxt; cA = nA; cB = nB; ++ui;
        if constexpr (ALIGN_EPI) { if (wr == 1) PG8_BAR; }
    }
    PG8_WAIT_V(0);
    if constexpr (!ALIGN_EPI) { if (wr == 0) PG8_BAR; }
    PG8_BAR;
    if constexpr (Epi::AFTER_DRAIN) { E.fused(acc, cur, wr, wc, fr, fq, lds, wid, lane); S.done(cur); }
#undef PG8_SA
#undef PG8_SB
#undef PG8_STAGE
#undef PG8_LDA
#undef PG8_LDB
#undef PG8_MMA
#undef PG8_WAIT_V
#undef PG8_WAIT_L
#undef PG8_BAR
#undef PG8_SCHED
}
}

constexpr int DM = 1024, NB_P = 2, SEQ = 16384, DEPTH = 2, NB_S = 8, SEQ_S = 64, PAST = 4096, FF = 4096;
constexpr int MP = NB_P * SEQ, MS = NB_S * SEQ_S, MT = MP + MS;
constexpr int NIN = 3088, NZ = 3328;
constexpr int ZQ = 0, ZK = 256, ZV = 512, ZR = 1024, ZSQ = 1536, ZSK = 1792, ZSV = 2048, ZCB = 2304, ZCC = 2560, ZCH = 2816, ZGLOW = 3072;
constexpr float LN_EPS = 1e-5f;
constexpr float ALPHA = 1.41421356237309515f;
constexpr int NWAVES = 8, NTHR = 512;
constexpr size_t O_Y = 0, O_KP = 34078720, O_VP = 50855936, O_GP = 67633152, O_CP = 67764224, O_KS = 67766272, O_VS = 68028416, O_GS = 68290560, O_CS = 68814848, O_END = 68823040;
constexpr size_t MiB = 1u << 20;
constexpr size_t WS_W = 1 * MiB;
constexpr size_t W_LAYER = (size_t)NZ * DM * 2 + (size_t)DM * DM * 2 + (size_t)FF * DM * 2 * 2;
constexpr size_t WOFF_OUT = (size_t)NZ * DM * 2, WOFF_UP = WOFF_OUT + (size_t)DM * DM * 2, WOFF_DOWN = WOFF_UP + (size_t)FF * DM * 2;
constexpr size_t WS_X = 50 * MiB;
constexpr size_t WS_Z = 115 * MiB;
constexpr size_t WS_MIX = WS_Z + (size_t)MT * NZ * 2;
constexpr size_t WS_H = WS_Z;
constexpr size_t WS_U = 392 * MiB;
constexpr int NGT = 8 * 256 + 32;
constexpr size_t WS_S = WS_U + (size_t)NGT * 8192 * 4;
constexpr size_t WS_D = WS_S + (size_t)NGT * 8192 * 2;
constexpr size_t WS_END = WS_D + (size_t)NGT * 64 * 4;
static_assert(WS_W + 2 * W_LAYER <= WS_X && WS_X + (size_t)MT * DM * 2 <= WS_Z && WS_MIX + (size_t)MT * DM * 2 <= WS_U && WS_H + (size_t)MT * FF * 2 <= WS_U && WS_END <= 512 * MiB, "ws map");
constexpr int LDS_BYTES = 147456;

#define LAS __attribute__((address_space(3)))
typedef unsigned short bf16;
typedef float f32x4 __attribute__((ext_vector_type(4)));
typedef short bf16x8 __attribute__((ext_vector_type(8)));
typedef short bf16x4 __attribute__((ext_vector_type(4)));
typedef unsigned u32x4 __attribute__((ext_vector_type(4)));
typedef unsigned u32x2 __attribute__((ext_vector_type(2)));
using pg8::cvt_pk_bf16; using pg8::bf_lo; using pg8::bf_hi;
__device__ __forceinline__ bf16 f2bf(float f) { return (bf16)(cvt_pk_bf16(f, 0.f) & 0xffffu); }
__device__ __forceinline__ float bf2f(bf16 b) { return __builtin_bit_cast(float, (unsigned)b << 16); }
constexpr float LOG2E = 1.4426950408889634f, LN2 = 0.6931471805599453f;
__device__ __forceinline__ float fexp(float x) { return __builtin_amdgcn_exp2f(x * LOG2E); }
__device__ __forceinline__ float softplus(float z) { const float e = __builtin_amdgcn_exp2f(-__builtin_fabsf(z) * LOG2E); return __builtin_fmaxf(z, 0.f) + LN2 * __builtin_amdgcn_logf(1.f + e); }
__device__ __forceinline__ f32x4 mfma16(bf16x8 a, bf16x8 b, f32x4 c) { return __builtin_amdgcn_mfma_f32_16x16x32_bf16(a, b, c, 0, 0, 0); }
__device__ __forceinline__ int otid() { int t = threadIdx.x; asm volatile("" : "+v"(t)); return t; }
__device__ __forceinline__ float wave_sum(float v) {
#pragma unroll
    for (int o = 1; o < 64; o <<= 1) v += __shfl_xor(v, o);
    return v;
}

struct Args {
    const float* xp; const float* xs; const float* ck; const float* cv; const float* sg; const float* sc;
    const float* ln_in_g; const float* ln_in_b; const float* w_in; const float* w_gate_up; const float* b_gate; const float* gla_norm_g; const float* conv_w; const float* w_out;
    const float* ln1_g; const float* ln1_b; const float* w_up; const float* w_down; const float* ln2_g; const float* ln2_b;
    float* out; unsigned char* ws;
};
typedef const __attribute__((address_space(4))) Args* CArgs;
__device__ __forceinline__ CArgs get_args() { CArgs p = (CArgs)__builtin_amdgcn_kernarg_segment_ptr(); asm volatile("" : "+s"(p)); return p; }

__device__ __forceinline__ void p0_transpose_item(const float* W, int ldw, int K, bf16* WT, int n0, int src0, int nvalid, int k0, LAS float* scr, int lane) {
    const int c = lane & 31; const bool ok = c < nvalid;
#pragma unroll 8
    for (int i = 0; i < 32; ++i) { const int kk = 2 * i + (lane >> 5); scr[kk * 33 + c] = ok ? W[(size_t)(k0 + kk) * ldw + src0 + c] : 0.f; }
    asm volatile("s_waitcnt lgkmcnt(0)" ::: "memory");
    const int c8 = lane & 7;
#pragma unroll
    for (int j = 0; j < 4; ++j) { const int n = (lane >> 3) + 8 * j; const LAS float* s = scr + (8 * c8) * 33 + n;
        u32x4 o; o.x = cvt_pk_bf16(s[0 * 33], s[1 * 33]); o.y = cvt_pk_bf16(s[2 * 33], s[3 * 33]); o.z = cvt_pk_bf16(s[4 * 33], s[5 * 33]); o.w = cvt_pk_bf16(s[6 * 33], s[7 * 33]);
        *(u32x4*)(WT + (size_t)(n0 + n) * K + k0 + 8 * c8) = o; }
    asm volatile("s_waitcnt lgkmcnt(0)" ::: "memory");
}
__device__ __forceinline__ void ln_row(const float* xrow, const float* g, const float* b, bf16* outb, float* outf, int lane) {
    const f32x4* xr = (const f32x4*)xrow + lane;
    f32x4 v[4]; float s = 0.f;
#pragma unroll
    for (int j = 0; j < 4; ++j) { v[j] = xr[64 * j]; s += (v[j].x + v[j].y) + (v[j].z + v[j].w); }
    const float mean = wave_sum(s) * (1.f / DM); float s2 = 0.f;
#pragma unroll
    for (int j = 0; j < 4; ++j) { v[j] = v[j] - mean; s2 += (v[j].x * v[j].x + v[j].y * v[j].y) + (v[j].z * v[j].z + v[j].w * v[j].w); }
    const float rstd = 1.f / sqrtf(wave_sum(s2) * (1.f / DM) + LN_EPS);
#pragma unroll
    for (int j = 0; j < 4; ++j) { const f32x4 gg = ((const f32x4*)g)[lane + 64 * j], bb = ((const f32x4*)b)[lane + 64 * j]; const f32x4 o = v[j] * rstd * gg + bb;
        if (outb) { u32x2 w; w.x = cvt_pk_bf16(o.x, o.y); w.y = cvt_pk_bf16(o.z, o.w); ((u32x2*)outb)[lane + 64 * j] = w; }
        if (outf) ((f32x4*)outf)[lane + 64 * j] = o; }
}

__device__ __forceinline__ void p0_prologue(CArgs A, LAS unsigned char* lds, int gw, int ngw, int wave, int lane) {
    LAS float* scr = (LAS float*)(lds + wave * 16384);
    constexpr int I_IN = 16 * (NZ / 32), I_OUT = 16 * 32, I_UP = 16 * (FF / 32), I_DOWN = (FF / 64) * 32, I_L = I_IN + I_OUT + I_UP + I_DOWN;
    for (int it = gw; it < 2 * I_L; it += ngw) {
        const int l = it / I_L; int r = it % I_L; unsigned char* wb = A->ws + WS_W + (size_t)l * W_LAYER;
        if (r < I_IN) { const int nblk = NZ / 32, kb = r / nblk, nb = r % nblk, n0 = 32 * nb; int src0, nv;
            if (n0 < 1536) { src0 = n0; nv = 32; } else if (n0 < 3072) { src0 = n0 + 16; nv = 32; } else if (n0 == 3072) { src0 = 1536; nv = 16; } else { src0 = 0; nv = 0; }
            p0_transpose_item(A->w_in + (size_t)l * DM * NIN, NIN, DM, (bf16*)wb, n0, src0, nv, 64 * kb, scr, lane); continue; }
        r -= I_IN;
        if (r < I_OUT) { const int kb = r / 32, nb = r % 32; p0_transpose_item(A->w_out + (size_t)l * DM * DM, DM, DM, (bf16*)(wb + WOFF_OUT), 32 * nb, 32 * nb, 32, 64 * kb, scr, lane); continue; }
        r -= I_OUT;
        if (r < I_UP) { const int kb = r / 128, nb = r % 128; p0_transpose_item(A->w_up + (size_t)l * DM * FF, FF, DM, (bf16*)(wb + WOFF_UP), 32 * nb, 32 * nb, 32, 64 * kb, scr, lane); continue; }
        r -= I_UP;
        { const int kb = r / 32, nb = r % 32; p0_transpose_item(A->w_down + (size_t)l * FF * DM, DM, FF, (bf16*)(wb + WOFF_DOWN), 32 * nb, 32 * nb, 32, 64 * kb, scr, lane); }
    }
    bf16* X = (bf16*)(A->ws + WS_X);
    for (int m = gw; m < MT; m += ngw) { const float* src = (m < MP) ? A->xp + (size_t)m * DM : A->xs + (size_t)(m - MP) * DM; ln_row(src, A->ln_in_g, A->ln_in_b, X + (size_t)m * DM, nullptr, lane); }
}

constexpr int SB_KS = 72, SB_VS = 136;
constexpr int SB_OFF_K = 0, SB_OFF_V = 128 * SB_KS * 2, SB_OFF_F = SB_OFF_V + 64 * SB_VS * 2;
__device__ __forceinline__ bf16x8 cvt8(const float* p) { const f32x4 a = *(const f32x4*)p, b = *(const f32x4*)(p + 4); u32x4 w; w.x = cvt_pk_bf16(a.x, a.y); w.y = cvt_pk_bf16(a.z, a.w); w.z = cvt_pk_bf16(b.x, b.y); w.w = cvt_pk_bf16(b.z, b.w); return __builtin_bit_cast(bf16x8, w); }
__device__ __forceinline__ void sb_attn_unit(LAS unsigned char* lds, const bf16* Z, const float* cacheK, const float* cacheV, bf16* MIX, int sample, int b, int h, int qb) {
    const int tid = otid(), lane = tid & 63, wave = __builtin_amdgcn_readfirstlane(tid >> 6), r = lane & 15, quad = lane >> 4;
    LAS bf16* Ks = (LAS bf16*)(lds + SB_OFF_K); LAS bf16* Vt = (LAS bf16*)(lds + SB_OFF_V); volatile LAS unsigned* flags = (volatile LAS unsigned*)(lds + SB_OFF_F);
    const int nq = sample ? 64 : 128;
    const size_t rowbase = sample ? (size_t)(MP + b * 64) : (size_t)b * SEQ + (size_t)qb * 128;
    const int qpos0 = sample ? PAST : qb * 128, kb_diag = sample ? 32 : qb;
    const bool wactive = wave * 16 < nq;
    bf16x8 qf[2];
    { const bf16* qp = Z + (rowbase + (wactive ? wave * 16 + r : 0)) * NZ + ZSQ + h * 64 + quad * 8; qf[0] = *(const bf16x8*)qp; qf[1] = *(const bf16x8*)(qp + 32); }
    const int tq = qpos0 + wave * 16 + r;
    float carry = 0.f;
    f32x4 oacc[4];
#pragma unroll
    for (int i = 0; i < 4; ++i) oacc[i] = (f32x4){0.f, 0.f, 0.f, 0.f};
    for (int kb = kb_diag; kb >= 0; --kb) {
#pragma unroll
        for (int i = 0; i < 2; ++i) {
            const int ch = tid + i * 512, key = ch >> 3, c8 = (ch & 7) * 8;
            bf16x8 kv, vv;
            if (!sample) { const bf16* p = Z + ((size_t)b * SEQ + (size_t)kb * 128 + key) * NZ + h * 64 + c8; kv = *(const bf16x8*)(p + ZSK); vv = *(const bf16x8*)(p + ZSV); }
            else if (kb < 32) { const size_t o = (((size_t)b * PAST + (size_t)kb * 128 + key) * 4 + h) * 64 + c8; kv = cvt8(cacheK + o); vv = cvt8(cacheV + o); }
            else if (key < 64) { const bf16* p = Z + ((size_t)MP + b * 64 + key) * NZ + h * 64 + c8; kv = *(const bf16x8*)(p + ZSK); vv = *(const bf16x8*)(p + ZSV); }
            else { kv = (bf16x8){0, 0, 0, 0, 0, 0, 0, 0}; vv = kv; }
            *(LAS bf16x8*)(Ks + key * SB_KS + c8) = kv;
#pragma unroll
            for (int e = 0; e < 8; ++e) Vt[(c8 + e) * SB_VS + key] = (bf16)vv[e];
        }
        __syncthreads();
        bool done = true;
        if (wactive) {
            f32x4 z[8], xl[8];
#pragma unroll
            for (int kt = 0; kt < 8; ++kt) { z[kt] = (f32x4){0.f, 0.f, 0.f, 0.f};
#pragma unroll
                for (int ks = 0; ks < 2; ++ks) { const bf16x8 a = *(const LAS bf16x8*)(Ks + (16 * kt + r) * SB_KS + ks * 32 + quad * 8); z[kt] = mfma16(a, qf[ks], z[kt]); } }
            const bool diag = (kb == kb_diag);
            float G[8], T[8];
#pragma unroll
            for (int kt = 0; kt < 8; ++kt) {
                float g = 0.f;
#pragma unroll
                for (int j = 0; j < 4; ++j) { const float zz = z[kt][j] * 0.125f; const int kabs = kb * 128 + 16 * kt + 4 * quad + j; const bool valid = !diag || (kabs < tq);
                    const float sp = softplus(zz); xl[kt][j] = valid ? -sp : 0.f; z[kt][j] = valid ? (zz - sp) : -1e30f; g += xl[kt][j]; }
                const float b_ = __shfl_xor(g, 16), c_ = __shfl_xor(g, 32), d_ = __shfl_xor(g, 48);
                T[kt] = (g + b_) + (c_ + d_);
                G[kt] = quad == 0 ? (b_ + c_ + d_) : quad == 1 ? (c_ + d_) : quad == 2 ? b_ : 0.f;
            }
            float after = carry; unsigned pk[8][2];
#pragma unroll
            for (int kt = 7; kt >= 0; --kt) {
                const float a3 = after + G[kt], a2 = a3 + xl[kt][3], a1 = a2 + xl[kt][2], a0 = a1 + xl[kt][1];
                const float p0 = fexp(z[kt][0] + a0), p1 = fexp(z[kt][1] + a1), p2 = fexp(z[kt][2] + a2), p3 = fexp(z[kt][3] + a3);
                pk[kt][0] = cvt_pk_bf16(p0, p1); pk[kt][1] = cvt_pk_bf16(p2, p3);
                after += T[kt];
            }
            carry = after;
#pragma unroll
            for (int i = 0; i < 4; ++i) {
                u32x4 pw; pw.x = pk[2 * i][0]; pw.y = pk[2 * i][1]; pw.z = pk[2 * i + 1][0]; pw.w = pk[2 * i + 1][1];
                const bf16x8 pb = __builtin_bit_cast(bf16x8, pw);
#pragma unroll
                for (int dt = 0; dt < 4; ++dt) {
                    const LAS bf16* vp = Vt + (16 * dt + r) * SB_VS + 32 * i + 4 * quad;
                    const u32x2 lo = *(const LAS u32x2*)vp, hi = *(const LAS u32x2*)(vp + 16);
                    u32x4 vw; vw.x = lo.x; vw.y = lo.y; vw.z = hi.x; vw.w = hi.y;
                    oacc[dt] = mfma16(__builtin_bit_cast(bf16x8, vw), pb, oacc[dt]);
                }
            }
            done = __all(carry < -104.f);
        }
        if (lane == 0) flags[wave] = done ? 1u : 0u;
        __syncthreads();
        unsigned alld = 1u;
#pragma unroll
        for (int w = 0; w < 8; ++w) alld &= flags[w];
        if (alld) break;
    }
    if (wactive) {
        bf16* op = MIX + (rowbase + wave * 16 + r) * DM + 512 + h * 64 + 4 * quad;
#pragma unroll
        for (int dt = 0; dt < 4; ++dt) { u32x2 w; w.x = cvt_pk_bf16(oacc[dt][0], oacc[dt][1]); w.y = cvt_pk_bf16(oacc[dt][2], oacc[dt][3]); *(u32x2*)(op + 16 * dt) = w; }
    }
    __syncthreads();
}

constexpr int GS = 72;
constexpr int G_OFF_B = 0, G_OFF_PART = 16384, G_OFF_QS = 18432, G_OFF_KS = 27648, G_OFF_KLT = 36864, G_OFF_VT = 46080, G_OFF_ATT = 64512, G_OFF_ST = 73728, G_OFF_WG = 92160, G_OFF_SSQ = 96256, G_OFF_GLW = 96768;
__device__ __forceinline__ void gla_unit(LAS unsigned char* lds, const int mode, const bf16* Z, const float* Wg, const float* bg, const float* gnorm, float* U, bf16* Sb, float* Dd, bf16* MIX, size_t rowbase, int h, int gt) {
    const int tid = otid(), lane = tid & 63, wave = __builtin_amdgcn_readfirstlane(tid >> 6), r = lane & 15, quad = lane >> 4;
    LAS float* bsm = (LAS float*)(lds + G_OFF_B); LAS float* part = (LAS float*)(lds + G_OFF_PART);
    LAS bf16* qs = (LAS bf16*)(lds + G_OFF_QS); LAS bf16* ks = (LAS bf16*)(lds + G_OFF_KS); LAS bf16* klT = (LAS bf16*)(lds + G_OFF_KLT);
    LAS bf16* Vt = (LAS bf16*)(lds + G_OFF_VT); LAS bf16* att = (LAS bf16*)(lds + G_OFF_ATT); LAS bf16* St = (LAS bf16*)(lds + G_OFF_ST);
    LAS float* wg = (LAS float*)(lds + G_OFF_WG); LAS float* ssq = (LAS float*)(lds + G_OFF_SSQ); LAS float* glw = (LAS float*)(lds + G_OFF_GLW);
#pragma unroll
    for (int i = 0; i < 2; ++i) { const int e = tid + i * 512; wg[e] = Wg[(e >> 6) * 256 + h * 64 + (e & 63)]; glw[e] = bf2f(Z[(rowbase + (e >> 4)) * NZ + ZGLOW + (e & 15)]); }
#pragma unroll
    for (int i = 0; i < 2; ++i) { const int ch = tid + i * 512, s = ch >> 4, c8 = (ch & 15) * 8; const bf16x8 vv = *(const bf16x8*)(Z + (rowbase + s) * NZ + ZV + h * 128 + c8);
#pragma unroll
        for (int e = 0; e < 8; ++e) Vt[(c8 + e) * GS + s] = (bf16)vv[e]; }
    if (mode == 1) {
#pragma unroll
        for (int i = 0; i < 2; ++i) { const int ch = tid + i * 512, v = ch >> 3, c8 = (ch & 7) * 8; *(LAS bf16x8*)(St + v * GS + c8) = *(const bf16x8*)(Sb + (size_t)gt * 8192 + v * 64 + c8); }
    }
    __syncthreads();
    { const int k = lane, seg = wave; float loc[8]; float run = 0.f; const float bias = bg[h * 64 + k];
#pragma unroll
        for (int tt = 0; tt < 8; ++tt) { const int t = seg * 8 + tt; float pre = bias;
#pragma unroll
            for (int i = 0; i < 16; ++i) pre += glw[t * 16 + i] * wg[i * 64 + k];
            const float lg = -softplus(-pre) * (1.f / 16.f); run += lg; loc[tt] = run; }
        part[seg * 64 + k] = run;
        __syncthreads();
        float pre = 0.f;
#pragma unroll
        for (int s2 = 0; s2 < 8; ++s2) pre += (s2 < seg) ? part[s2 * 64 + k] : 0.f;
#pragma unroll
        for (int tt = 0; tt < 8; ++tt) bsm[(seg * 8 + tt) * 64 + k] = pre + loc[tt];
    }
    __syncthreads();
    { const int t = tid >> 3, c8 = (tid & 7) * 8; const bf16* zp = Z + (rowbase + t) * NZ + h * 64 + c8;
        const bf16x8 k8 = *(const bf16x8*)(zp + ZK);
        if (mode == 1) { const bf16x8 q8 = *(const bf16x8*)(zp + ZQ); float qv[8], kv[8];
#pragma unroll
            for (int e = 0; e < 8; ++e) { const float bb = bsm[t * 64 + c8 + e]; qv[e] = bf2f((bf16)q8[e]) * 0.125f * fexp(bb); kv[e] = bf2f((bf16)k8[e]) * fexp(-bb); }
            u32x4 w; w.x = cvt_pk_bf16(qv[0], qv[1]); w.y = cvt_pk_bf16(qv[2], qv[3]); w.z = cvt_pk_bf16(qv[4], qv[5]); w.w = cvt_pk_bf16(qv[6], qv[7]); *(LAS u32x4*)(qs + t * GS + c8) = w;
            w.x = cvt_pk_bf16(kv[0], kv[1]); w.y = cvt_pk_bf16(kv[2], kv[3]); w.z = cvt_pk_bf16(kv[4], kv[5]); w.w = cvt_pk_bf16(kv[6], kv[7]); *(LAS u32x4*)(ks + t * GS + c8) = w;
        } else {
#pragma unroll
            for (int e = 0; e < 8; ++e) { const float bb = bsm[t * 64 + c8 + e], bl = bsm[63 * 64 + c8 + e]; klT[(c8 + e) * GS + t] = f2bf(bf2f((bf16)k8[e]) * fexp(bl - bb)); }
            if (tid < 64) Dd[(size_t)gt * 64 + tid] = fexp(bsm[63 * 64 + tid]);
        }
    }
    __syncthreads();
    if (mode == 0) {
#pragma unroll
        for (int nt = 0; nt < 4; ++nt) { f32x4 c = (f32x4){0.f, 0.f, 0.f, 0.f};
#pragma unroll
            for (int k0 = 0; k0 < 2; ++k0) { const bf16x8 a = *(const LAS bf16x8*)(Vt + (16 * wave + r) * GS + k0 * 32 + quad * 8), bq = *(const LAS bf16x8*)(klT + (16 * nt + r) * GS + k0 * 32 + quad * 8); c = mfma16(a, bq, c); }
#pragma unroll
            for (int j = 0; j < 4; ++j) U[(size_t)gt * 8192 + (16 * wave + 4 * quad + j) * 64 + 16 * nt + r] = c[j]; }
    } else {
        { const int mt = wave >> 1;
#pragma unroll
            for (int n2 = 0; n2 < 2; ++n2) { const int nt = (wave & 1) * 2 + n2; f32x4 c = (f32x4){0.f, 0.f, 0.f, 0.f};
#pragma unroll
                for (int k0 = 0; k0 < 2; ++k0) { const bf16x8 a = *(const LAS bf16x8*)(qs + (16 * mt + r) * GS + k0 * 32 + quad * 8), bq = *(const LAS bf16x8*)(ks + (16 * nt + r) * GS + k0 * 32 + quad * 8); c = mfma16(a, bq, c); }
#pragma unroll
                for (int j = 0; j < 4; ++j) { const int t = 16 * mt + 4 * quad + j, s = 16 * nt + r; att[t * GS + s] = f2bf(s <= t ? c[j] : 0.f); } } }
        __syncthreads();
        const int mt = wave >> 1; f32x4 o[4]; float sq[4] = {0.f, 0.f, 0.f, 0.f};
#pragma unroll
        for (int n4 = 0; n4 < 4; ++n4) { const int nt = (wave & 1) * 4 + n4; f32x4 c = (f32x4){0.f, 0.f, 0.f, 0.f};
#pragma unroll
            for (int k0 = 0; k0 < 2; ++k0) { const bf16x8 a = *(const LAS bf16x8*)(att + (16 * mt + r) * GS + k0 * 32 + quad * 8), bq = *(const LAS bf16x8*)(Vt + (16 * nt + r) * GS + k0 * 32 + quad * 8); c = mfma16(a, bq, c); }
#pragma unroll
            for (int k0 = 0; k0 < 2; ++k0) { const bf16x8 a = *(const LAS bf16x8*)(qs + (16 * mt + r) * GS + k0 * 32 + quad * 8), bq = *(const LAS bf16x8*)(St + (16 * nt + r) * GS + k0 * 32 + quad * 8); c = mfma16(a, bq, c); }
            o[n4] = c;
#pragma unroll
            for (int j = 0; j < 4; ++j) sq[j] += c[j] * c[j]; }
#pragma unroll
        for (int j = 0; j < 4; ++j) { float v = sq[j]; v += __shfl_xor(v, 1); v += __shfl_xor(v, 2); v += __shfl_xor(v, 4); v += __shfl_xor(v, 8); sq[j] = v; }
        if (r == 0) {
#pragma unroll
            for (int j = 0; j < 4; ++j) ssq[(16 * mt + 4 * quad + j) * 2 + (wave & 1)] = sq[j]; }
        __syncthreads();
#pragma unroll
        for (int j = 0; j < 4; ++j) { const int t = 16 * mt + 4 * quad + j; const float rstd = 1.f / sqrtf((ssq[t * 2] + ssq[t * 2 + 1]) * (1.f / 128.f) + LN_EPS);
#pragma unroll
            for (int n4 = 0; n4 < 4; ++n4) { const int v = 16 * ((wave & 1) * 4 + n4) + r; const float gr = bf2f(Z[(rowbase + t) * NZ + ZR + h * 128 + v]);
                const float on = o[n4][j] * rstd;
                const float val = on * gnorm[h * 128 + v] * (gr / (1.f + fexp(-gr)));
                MIX[(rowbase + t) * DM + h * 128 + v] = f2bf(val); } }
    }
    __syncthreads();
}

__device__ __forceinline__ void gla_scan(CArgs A, int l, int gtid, int nthreads) {
    const float* U = (const float*)(A->ws + WS_U); bf16* Sb = (bf16*)(A->ws + WS_S); const float* Dd = (const float*)(A->ws + WS_D);
    for (int it = gtid; it < 65536 + 32 * 8192; it += nthreads) {
        if (it < 65536) { const int seq = it >> 13, e = it & 8191, k = e & 63, v = e >> 6; float S = 0.f;
#pragma unroll 8
            for (int c = 0; c < 256; ++c) { const size_t gt = (size_t)seq * 256 + c; Sb[gt * 8192 + e] = f2bf(S); S = Dd[gt * 64 + k] * S + U[gt * 8192 + e]; }
            A->out[O_GP + (size_t)l * 65536 + (size_t)seq * 8192 + k * 128 + v] = S;
        } else { const int p = it - 65536, sq = p >> 13, e = p & 8191, k = e & 63, v = e >> 6; const size_t gt = 2048 + sq;
            const float S0 = A->sg[(size_t)l * 262144 + (size_t)sq * 8192 + k * 128 + v];
            Sb[gt * 8192 + e] = f2bf(S0);
            A->out[O_GS + (size_t)l * 262144 + (size_t)sq * 8192 + k * 128 + v] = Dd[gt * 64 + k] * S0 + U[gt * 8192 + e]; }
    }
}

__device__ __forceinline__ void conv_phase(CArgs A, int l, int gtid, int nthreads) {
    const bf16* Z = (const bf16*)(A->ws + WS_Z); bf16* MIX = (bf16*)(A->ws + WS_MIX); const float* cw = A->conv_w + (size_t)l * 3 * 256;
    for (int it = gtid; it < MT * 32; it += nthreads) {
        const int row = it >> 5, c8 = (it & 31) * 8; int t, b, sample;
        if (row < MP) { sample = 0; b = row >> 14; t = row & (SEQ - 1); } else { sample = 1; b = (row - MP) >> 6; t = (row - MP) & 63; }
        const bf16* zp = Z + (size_t)row * NZ + c8;
        const u32x4 cb = *(const u32x4*)(zp + ZCB), cc0 = *(const u32x4*)(zp + ZCC), ch0 = *(const u32x4*)(zp + ZCH);
        float u0[8], u1[8], u2[8], cbf[8];
        { const unsigned* c = (const unsigned*)&cc0; const unsigned* hh = (const unsigned*)&ch0; const unsigned* bb = (const unsigned*)&cb;
#pragma unroll
          for (int e = 0; e < 4; ++e) { u0[2 * e] = bf_lo(c[e]) * bf_lo(hh[e]); u0[2 * e + 1] = bf_hi(c[e]) * bf_hi(hh[e]); cbf[2 * e] = bf_lo(bb[e]); cbf[2 * e + 1] = bf_hi(bb[e]); } }
#pragma unroll
        for (int d = 1; d <= 2; ++d) { float* ud = (d == 1) ? u1 : u2;
            if (t - d >= 0) { const bf16* zq = zp - (size_t)d * NZ; const u32x4 c1 = *(const u32x4*)(zq + ZCC), h1 = *(const u32x4*)(zq + ZCH); const unsigned* c = (const unsigned*)&c1; const unsigned* hh = (const unsigned*)&h1;
#pragma unroll
                for (int e = 0; e < 4; ++e) { ud[2 * e] = bf_lo(c[e]) * bf_lo(hh[e]); ud[2 * e + 1] = bf_hi(c[e]) * bf_hi(hh[e]); } }
            else if (sample) { const float* pv = A->sc + (((size_t)l * NB_S + b) * 2 + (2 + t - d)) * 256 + c8;
#pragma unroll
                for (int e = 0; e < 8; ++e) ud[e] = pv[e]; }
            else {
#pragma unroll
                for (int e = 0; e < 8; ++e) ud[e] = 0.f; } }
        float y[8];
#pragma unroll
        for (int e = 0; e < 8; ++e) y[e] = cbf[e] * (cw[512 + c8 + e] * u0[e] + cw[256 + c8 + e] * u1[e] + cw[c8 + e] * u2[e]);
        u32x4 w; w.x = cvt_pk_bf16(y[0], y[1]); w.y = cvt_pk_bf16(y[2], y[3]); w.z = cvt_pk_bf16(y[4], y[5]); w.w = cvt_pk_bf16(y[6], y[7]);
        *(u32x4*)(MIX + (size_t)row * DM + 768 + c8) = w;
        const int T = sample ? SEQ_S : SEQ;
        if (t >= T - 2) { float* o = sample ? A->out + O_CS + (((size_t)l * NB_S + b) * 2 + (t - (T - 2))) * 256 + c8 : A->out + O_CP + (((size_t)l * NB_P + b) * 2 + (t - (T - 2))) * 256 + c8;
#pragma unroll
            for (int e = 0; e < 8; ++e) o[e] = u0[e]; }
    }
}

__device__ __forceinline__ void phase_gemm_in(LAS unsigned char* lds, int l) {
    CArgs A = get_args(); const int G = gridDim.x, bx = blockIdx.x;
    pg8::Gemm g{(const bf16*)(A->ws + WS_X), (const bf16*)(A->ws + WS_W + (size_t)l * W_LAYER), MT, NZ, DM}; pg8::StaticOrder S; S.init(MT, NZ, G, bx);
    pg8::EpiZ E{(bf16*)(A->ws + WS_Z), A->out, l};
    pg8::gemm_phase<pg8::EpiZ, pg8::StaticOrder, true, true>(lds, g, S, E);
}
__device__ __forceinline__ void phase_gemm_out(LAS unsigned char* lds, int l) {
    CArgs A = get_args(); const int G = gridDim.x, bx = blockIdx.x;
    pg8::Gemm g{(const bf16*)(A->ws + WS_MIX), (const bf16*)(A->ws + WS_W + (size_t)l * W_LAYER + WOFF_OUT), MT, DM, DM}; pg8::StaticOrder S; S.init(MT, DM, G, bx);
    pg8::EpiT E{(const bf16*)(A->ws + WS_X), A->out + O_Y};
    pg8::gemm_phase<pg8::EpiT, pg8::StaticOrder, true, true>(lds, g, S, E);
}
__device__ __forceinline__ void phase_gemm_up(LAS unsigned char* lds, int l) {
    CArgs A = get_args(); const int G = gridDim.x, bx = blockIdx.x;
    pg8::Gemm g{(const bf16*)(A->ws + WS_X), (const bf16*)(A->ws + WS_W + (size_t)l * W_LAYER + WOFF_UP), MT, FF, DM}; pg8::StaticOrder S; S.init(MT, FF, G, bx);
    pg8::EpiH E{(bf16*)(A->ws + WS_H)};
    pg8::gemm_phase<pg8::EpiH, pg8::StaticOrder, true, true>(lds, g, S, E);
}
__device__ __forceinline__ void phase_gemm_down(LAS unsigned char* lds, int l) {
    CArgs A = get_args(); const int G = gridDim.x, bx = blockIdx.x;
    pg8::Gemm g{(const bf16*)(A->ws + WS_H), (const bf16*)(A->ws + WS_W + (size_t)l * W_LAYER + WOFF_DOWN), MT, DM, FF}; pg8::StaticOrder S; S.init(MT, DM, G, bx);
    pg8::EpiT E{(const bf16*)(A->ws + WS_X), A->out + O_Y};
    pg8::gemm_phase<pg8::EpiT, pg8::StaticOrder, true, true>(lds, g, S, E);
}
__device__ __forceinline__ void gt_rows(int gt, size_t& rowbase, int& h) {
    if (gt < 2048) { const int bh = gt >> 8, c = gt & 255; h = bh & 3; rowbase = (size_t)(bh >> 2) * SEQ + (size_t)c * 64; } else { const int s = gt - 2048; h = s & 3; rowbase = (size_t)MP + (size_t)(s >> 2) * 64; }
}
__device__ __forceinline__ void phase_mix_local(LAS unsigned char* lds, int l) {
    CArgs A = get_args(); const int G = gridDim.x, bx = blockIdx.x;
    const bf16* Z = (const bf16*)(A->ws + WS_Z); bf16* MIX = (bf16*)(A->ws + WS_MIX);
    const float* ck = A->ck + (size_t)l * NB_S * PAST * 256; const float* cv = A->cv + (size_t)l * NB_S * PAST * 256;
    constexpr int NSB = 1024 + 32;
    for (int u = bx; u < NSB; u += G) {
        if (u < 1024) { const int qb = 127 - (u >> 3), bh = u & 7; sb_attn_unit(lds, Z, ck, cv, MIX, 0, bh >> 2, bh & 3, qb); }
        else { const int s = u - 1024; sb_attn_unit(lds, Z, ck, cv, MIX, 1, s >> 2, s & 3, 0); }
    }
    const float* Wg = A->w_gate_up + (size_t)l * 16 * 256; const float* bg = A->b_gate + (size_t)l * 256; const float* gn = A->gla_norm_g + (size_t)l * 512;
    float* U = (float*)(A->ws + WS_U); bf16* Sb = (bf16*)(A->ws + WS_S); float* Dd = (float*)(A->ws + WS_D);
    for (int gt = bx; gt < NGT; gt += G) { size_t rowbase; int h; gt_rows(gt, rowbase, h); gla_unit(lds, 0, Z, Wg, bg, gn, U, Sb, Dd, MIX, rowbase, h, gt); }
    conv_phase(A, l, bx * NTHR + otid(), G * NTHR);
}
__device__ __forceinline__ void phase_gla_out(LAS unsigned char* lds, int l) {
    CArgs A = get_args(); const int G = gridDim.x, bx = blockIdx.x;
    const bf16* Z = (const bf16*)(A->ws + WS_Z); bf16* MIX = (bf16*)(A->ws + WS_MIX);
    const float* Wg = A->w_gate_up + (size_t)l * 16 * 256; const float* bg = A->b_gate + (size_t)l * 256; const float* gn = A->gla_norm_g + (size_t)l * 512;
    float* U = (float*)(A->ws + WS_U); bf16* Sb = (bf16*)(A->ws + WS_S); float* Dd = (float*)(A->ws + WS_D);
    for (int gt = bx; gt < NGT; gt += G) { size_t rowbase; int h; gt_rows(gt, rowbase, h); gla_unit(lds, 1, Z, Wg, bg, gn, U, Sb, Dd, MIX, rowbase, h, gt); }
}
__device__ __forceinline__ void phase_ln(int l, int which) {
    CArgs A = get_args(); const int tid = otid(); const int G = gridDim.x, bx = blockIdx.x, lane = tid & 63, wave = tid >> 6;
    const int gw = bx * NWAVES + wave, ngw = G * NWAVES;
    float* T = A->out + O_Y; bf16* X = (bf16*)(A->ws + WS_X);
    const float* g = (which ? A->ln2_g : A->ln1_g) + (size_t)l * DM; const float* b = (which ? A->ln2_b : A->ln1_b) + (size_t)l * DM;
    const bool last = which && (l == DEPTH - 1);
    for (int m = gw; m < MT; m += ngw) ln_row(T + (size_t)m * DM, g, b, last ? nullptr : X + (size_t)m * DM, last ? T + (size_t)m * DM : nullptr, lane);
}

__global__ void __launch_bounds__(NTHR, 2) hymba_fwd(Args Aunused) {
    extern __shared__ __attribute__((aligned(16))) unsigned char lds_raw[];
    LAS unsigned char* lds = (LAS unsigned char*)lds_raw;
    cg::grid_group grid = cg::this_grid();
    { CArgs A = get_args(); const int tid = otid(), wave = tid >> 6; p0_prologue(A, lds, blockIdx.x * NWAVES + wave, gridDim.x * NWAVES, wave, tid & 63); }
    grid.sync();
    for (int l = 0; l < DEPTH; ++l) {
#ifndef NO_GZ
        phase_gemm_in(lds, l);
#endif
        grid.sync();
#ifndef NO_MIXL
        phase_mix_local(lds, l);
#endif
        grid.sync();
        { CArgs A = get_args(); gla_scan(A, l, blockIdx.x * NTHR + otid(), gridDim.x * NTHR); }
        grid.sync();
#ifndef NO_GLAO
        phase_gla_out(lds, l);
#endif
        grid.sync();
#ifndef NO_GT
        phase_gemm_out(lds, l);
#endif
        grid.sync();
        phase_ln(l, 0);             grid.sync();
#ifndef NO_GH
        phase_gemm_up(lds, l);
#endif
        grid.sync();
#ifndef NO_GT
        phase_gemm_down(lds, l);
#endif
        grid.sync();
        phase_ln(l, 1);
        if (l + 1 < DEPTH) grid.sync();
    }
}

extern "C" void kernel_launch(void* const* d_in, const int* in_sizes, int n_in, void* d_out, int out_size, void* d_ws, size_t ws_size, hipStream_t stream) {
    static int grid = 0;
    if (grid == 0) {
        int dev = 0, cus = 0, per_cu = 0;
        hipGetDevice(&dev); hipDeviceGetAttribute(&cus, hipDeviceAttributeMultiprocessorCount, dev);
        hipFuncSetAttribute((const void*)hymba_fwd, hipFuncAttributeMaxDynamicSharedMemorySize, LDS_BYTES);
        if (hipOccupancyMaxActiveBlocksPerMultiprocessor(&per_cu, (const void*)hymba_fwd, NTHR, LDS_BYTES) != hipSuccess || per_cu < 1) { (void)hipGetLastError(); per_cu = 1; }
        grid = cus * per_cu;
        if (ws_size < WS_END || n_in != 20 || (size_t)out_size != O_END) fprintf(stderr, "kernel_launch: unexpected sizes ws %zu n_in %d out %d\n", ws_size, n_in, out_size);
    }
    Args a{};
    a.xp = (const float*)d_in[0]; a.xs = (const float*)d_in[1]; a.ck = (const float*)d_in[2]; a.cv = (const float*)d_in[3]; a.sg = (const float*)d_in[4]; a.sc = (const float*)d_in[5];
    a.ln_in_g = (const float*)d_in[6]; a.ln_in_b = (const float*)d_in[7]; a.w_in = (const float*)d_in[8]; a.w_gate_up = (const float*)d_in[9]; a.b_gate = (const float*)d_in[10];
    a.gla_norm_g = (const float*)d_in[11]; a.conv_w = (const float*)d_in[12]; a.w_out = (const float*)d_in[13]; a.ln1_g = (const float*)d_in[14]; a.ln1_b = (const float*)d_in[15];
    a.w_up = (const float*)d_in[16]; a.w_down = (const float*)d_in[17]; a.ln2_g = (const float*)d_in[18]; a.ln2_b = (const float*)d_in[19];
    a.out = (float*)d_out; a.ws = (unsigned char*)d_ws;
    void* args[] = {&a};
    hipError_t e = hipLaunchCooperativeKernel((const void*)hymba_fwd, dim3(grid), dim3(NTHR), args, LDS_BYTES, stream);
    if (e != hipSuccess) fprintf(stderr, "cooperative launch failed: %s (grid %d)\n", hipGetErrorString(e), grid);
}
```

```cpp
#include <hip/hip_runtime.h>
#include <hip/hip_cooperative_groups.h>
#include <cstdio>
#include <cstdint>
namespace cg = cooperative_groups;
namespace pg8 {
#define PG8_LAS __attribute__((address_space(3)))
typedef unsigned short bf16_t;
typedef short bf16x8 __attribute__((ext_vector_type(8)));
typedef float f32x4 __attribute__((ext_vector_type(4)));
typedef unsigned u32x4 __attribute__((ext_vector_type(4)));
constexpr int BM = 256, BK = 64, HALF = 128, HTB = HALF * BK * 2  , STAGE_BYTES = 8 * HTB, NXCD = 8, WGM = 8;

__host__ __device__ __forceinline__ int lds_byte(int r, int c) { const int st = (r >> 4) * 2 + (c >> 5), rr = r & 15, cc = c & 31, ob = rr * 64 + cc * 2; return st * 1024 + (ob ^ (((ob >> 9) & 1) << 5)); }
__host__ __device__ __forceinline__ void stage_rc(int b, int& R, int& C) { const int st = b / 1024, sb = b % 1024, swz = sb ^ (((sb >> 9) & 1) << 5); R = (st >> 1) * 16 + swz / 64; C = (st & 1) * 32 + (swz % 64) / 2; }
__host__ __device__ __forceinline__ int perm32(int rho) { const int n = rho >> 4, i = rho & 15; return 8 * (i >> 2) + 4 * n + (i & 3); }

struct Unit { int pm, pn; };
struct Gemm { const bf16_t* A; const bf16_t* Bt; int M, N, K; };

struct StaticOrder {
    int nM, nN, nwg, G, c;
    __host__ __device__ void init(int M, int N, int G_, int c_) { nM = M / BM; nN = N / BM; nwg = nM * nN; G = G_; c = c_; }
    __host__ __device__ bool next(int i, Unit& u) const {
        const long L = (long)i * G + c; if (L >= nwg) return false;
        int wgid = (int)L; { const int q = nwg / NXCD, r = nwg % NXCD, xcd = wgid % NXCD, off = wgid / NXCD; wgid = (xcd < r ? xcd * (q + 1) : r * (q + 1) + (xcd - r) * q) + off; }
        const int nig = WGM * nN, gid = wgid / nig, fm = gid * WGM, gsz = (nM - fm) < WGM ? (nM - fm) : WGM;
        u.pm = fm + ((wgid % nig) % gsz); u.pn = (wgid % nig) / gsz; return true;
    }
    __device__ __forceinline__ void a_ready(const Unit&) const {}
    __device__ __forceinline__ void done(const Unit&) const {}
};

__device__ __forceinline__ unsigned cvt_pk_bf16(float lo, float hi) { unsigned r; asm volatile("v_cvt_pk_bf16_f32 %0, %1, %2" : "=v"(r) : "v"(lo), "v"(hi)); return r; }
typedef unsigned u32x4 __attribute__((ext_vector_type(4)));
__device__ __forceinline__ float bf_lo(unsigned w) { return __builtin_bit_cast(float, w << 16); }
__device__ __forceinline__ float bf_hi(unsigned w) { return __builtin_bit_cast(float, w & 0xffff0000u); }

struct EpiZ {
    static constexpr bool PERM = true, AFTER_DRAIN = false;
    bf16_t* Zp; float* out; int l;
    __device__ __forceinline__ void operator()(const f32x4 (&acc)[2][2][4][2], const Unit& u, int wr, int wc, int fr, int fq) const {
        constexpr int ldz = 3072; constexpr size_t O_KP = 34078720, O_VP = 50855936, O_KS = 67766272, O_VS = 68028416;
        const int row0 = u.pm * BM + wr * 64 + fr, colt = wc * 32 + 8 * fq, col0 = u.pn * BM + colt;
        const bool smp = u.pm >= 128; const bool kvt = (u.pn == 7) || (u.pn == 8);
        const size_t fbase = smp ? ((u.pn == 7 ? O_KS : O_VS) + (size_t)l * 131072) : ((u.pn == 7 ? O_KP : O_VP) + (size_t)l * 8388608);
        float* fo = out + fbase + (size_t)(row0 - (smp ? 32768 : 0)) * 256 + colt;
#pragma unroll
        for (int ai = 0; ai < 2; ++ai)
#pragma unroll
            for (int m = 0; m < 4; ++m) { const int ro = ai * HALF + m * 16; bf16_t* rowp = Zp + (size_t)(row0 + ro) * ldz + col0;
#pragma unroll
                for (int bj = 0; bj < 2; ++bj) { const f32x4 v0 = acc[ai][bj][m][0], v1 = acc[ai][bj][m][1];
                    u32x4 w; w.x = cvt_pk_bf16(v0[0], v0[1]); w.y = cvt_pk_bf16(v0[2], v0[3]); w.z = cvt_pk_bf16(v1[0], v1[1]); w.w = cvt_pk_bf16(v1[2], v1[3]);
                    *(u32x4*)(rowp + bj * HALF) = w;
                    if (kvt) { float* p = fo + (size_t)ro * 256 + bj * HALF; *(f32x4*)p = v0; *(f32x4*)(p + 4) = v1; } }
                asm volatile("" ::: "memory"); }
    }
};
struct EpiT {
    static constexpr bool PERM = true, AFTER_DRAIN = false;
    const bf16_t* X; float* T;
    __device__ __forceinline__ void operator()(const f32x4 (&acc)[2][2][4][2], const Unit& u, int wr, int wc, int fr, int fq) const {
        constexpr float alpha = 1.41421356237309515f;
        const int row0 = u.pm * BM + wr * 64 + fr, col0 = u.pn * BM + wc * 32 + 8 * fq;
#pragma unroll
        for (int ai = 0; ai < 2; ++ai)
#pragma unroll
            for (int m = 0; m < 4; ++m) { const size_t off = (size_t)(row0 + ai * HALF + m * 16) * 1024 + col0;
#pragma unroll
                for (int bj = 0; bj < 2; ++bj) { const u32x4 xw = *(const u32x4*)(X + off + bj * HALF);
                    f32x4 v0 = acc[ai][bj][m][0], v1 = acc[ai][bj][m][1];
                    v0[0] += alpha * bf_lo(xw.x); v0[1] += alpha * bf_hi(xw.x); v0[2] += alpha * bf_lo(xw.y); v0[3] += alpha * bf_hi(xw.y);
                    v1[0] += alpha * bf_lo(xw.z); v1[1] += alpha * bf_hi(xw.z); v1[2] += alpha * bf_lo(xw.w); v1[3] += alpha * bf_hi(xw.w);
                    float* p = T + off + bj * HALF; *(f32x4*)p = v0; *(f32x4*)(p + 4) = v1; }
                asm volatile("" ::: "memory"); }
    }
};
struct EpiH {
    static constexpr bool PERM = true, AFTER_DRAIN = false;
    bf16_t* Hp;
    __device__ __forceinline__ void operator()(const f32x4 (&acc)[2][2][4][2], const Unit& u, int wr, int wc, int fr, int fq) const {
        constexpr int ldh = 4096; const int row0 = u.pm * BM + wr * 64 + fr, col0 = u.pn * BM + wc * 32 + 8 * fq;
#pragma unroll
        for (int ai = 0; ai < 2; ++ai)
#pragma unroll
            for (int m = 0; m < 4; ++m) { bf16_t* rowp = Hp + (size_t)(row0 + ai * HALF + m * 16) * ldh + col0;
#pragma unroll
                for (int bj = 0; bj < 2; ++bj) { f32x4 v0 = acc[ai][bj][m][0], v1 = acc[ai][bj][m][1];
#pragma unroll
                    for (int e = 0; e < 4; ++e) { const float a = v0[e] > 0.f ? v0[e] : 0.f, b = v1[e] > 0.f ? v1[e] : 0.f; v0[e] = a * a; v1[e] = b * b; }
                    u32x4 w; w.x = cvt_pk_bf16(v0[0], v0[1]); w.y = cvt_pk_bf16(v0[2], v0[3]); w.z = cvt_pk_bf16(v1[0], v1[1]); w.w = cvt_pk_bf16(v1[2], v1[3]);
                    *(u32x4*)(rowp + bj * HALF) = w; }
                asm volatile("" ::: "memory"); }
    }
};
template <class Epi, class Sched, bool ALIGN_EPI = false, bool SP2 = false>
__device__ __forceinline__ void gemm_phase(PG8_LAS unsigned char* lds, const Gemm g, const Sched& S, const Epi& E) {
    int tid_ = threadIdx.x; asm volatile("" : "+v"(tid_));
    const int tid = tid_, wid = __builtin_amdgcn_readfirstlane(tid >> 6), lane = tid & 63, wr = wid >> 2, wc = wid & 3, fr = lane & 15, fq = lane >> 4;
    const int K = g.K, nt = K / BK;
    unsigned voffA[2], voffB[2];
#pragma unroll
    for (int i = 0; i < 2; ++i) { int R, C; stage_rc(tid * 16 + i * 8192, R, C); const int Rb = Epi::PERM ? ((R & ~31) + perm32(R & 31)) : R;
        voffA[i] = (unsigned)(R * K + C) * 2u; voffB[i] = (unsigned)(Rb * K + C) * 2u; }
    const size_t kstep = (size_t)(BK * 2);
    const size_t hstep = (size_t)HALF * K * 2;
    const size_t tstep = 2 * hstep;
    const unsigned ldsw = (unsigned)wid * 1024u;
    const int aoff = lds_byte(wr * 64 + fr, fq * 8), boff = lds_byte(wc * 32 + fr, fq * 8);
#define PG8_SA(b, h) (((b) * 2 + (h)) * HTB)
#define PG8_SB(b, h) ((4 + (b) * 2 + (h)) * HTB)
#define PG8_STAGE(bufoff, gbase, voff) do { _Pragma("unroll") for (int _i = 0; _i < 2; ++_i) \
        __builtin_amdgcn_global_load_lds((const unsigned*)((const char*)(gbase) + (voff)[_i]), (PG8_LAS unsigned*)(lds + (bufoff) + ldsw + _i * 8192), 16, 0, 0); } while (0)
#define PG8_LDA(dst, b, h) do { _Pragma("unroll") for (int m = 0; m < 4; ++m) _Pragma("unroll") for (int k = 0; k < 2; ++k) dst[m][k] = *(const PG8_LAS bf16x8*)(lds + PG8_SA(b, h) + aoff + m * 2048 + k * 1024); } while (0)
#define PG8_LDB(dst, b, h) do { _Pragma("unroll") for (int n = 0; n < 2; ++n) _Pragma("unroll") for (int k = 0; k < 2; ++k) dst[n][k] = *(const PG8_LAS bf16x8*)(lds + PG8_SB(b, h) + boff + n * 2048 + k * 1024); } while (0)
#define PG8_MMA(ai, bj, At, Bt) do { __builtin_amdgcn_s_setprio(1); _Pragma("unroll") for (int m = 0; m < 4; ++m) _Pragma("unroll") for (int n = 0; n < 2; ++n) _Pragma("unroll") for (int k = 0; k < 2; ++k) \
        acc[ai][bj][m][n] = __builtin_amdgcn_mfma_f32_16x16x32_bf16(Bt[n][k], At[m][k], acc[ai][bj][m][n], 0, 0, 0); __builtin_amdgcn_s_setprio(0); } while (0)
#define PG8_WAIT_V(n) asm volatile("s_waitcnt vmcnt(" #n ")" ::: "memory")
#define PG8_WAIT_L(n) asm volatile("s_waitcnt lgkmcnt(" #n ")" ::: "memory")
#define PG8_BAR __builtin_amdgcn_s_barrier()
#define PG8_SCHED __builtin_amdgcn_sched_barrier(0)
    Unit cur, nxt; int ui = 0;
    if (!S.next(0, cur)) return;
    f32x4 acc[2][2][4][2];
#pragma unroll
    for (int a = 0; a < 2; ++a)
#pragma unroll
        for (int b = 0; b < 2; ++b)
#pragma unroll
            for (int m = 0; m < 4; ++m)
#pragma unroll
                for (int n = 0; n < 2; ++n) acc[a][b][m][n] = (f32x4){0.f, 0.f, 0.f, 0.f};
    bf16x8 At[4][2], B0[2][2], B1[2][2];
    const char* cA = (const char*)g.A + (size_t)cur.pm * tstep; const char* cB = (const char*)g.Bt + (size_t)cur.pn * tstep;
    S.a_ready(cur);
    if constexpr (SP2) {
        PG8_STAGE(PG8_SB(0, 0), cB, voffB); PG8_STAGE(PG8_SB(0, 1), cB + hstep, voffB); PG8_STAGE(PG8_SA(0, 0), cA, voffA); PG8_STAGE(PG8_SA(0, 1), cA + hstep, voffA);
        if (wr == 1) PG8_BAR;
        PG8_WAIT_V(2); PG8_BAR;
        PG8_STAGE(PG8_SB(1, 0), cB + kstep, voffB); PG8_STAGE(PG8_SA(1, 0), cA + kstep, voffA); PG8_STAGE(PG8_SB(1, 1), cB + hstep + kstep, voffB);
        PG8_WAIT_V(6); PG8_BAR;
    } else {
        PG8_STAGE(PG8_SB(0, 0), cB, voffB); PG8_STAGE(PG8_SA(0, 0), cA, voffA); PG8_STAGE(PG8_SB(0, 1), cB + hstep, voffB); PG8_STAGE(PG8_SA(0, 1), cA + hstep, voffA);
        if (wr == 1) PG8_BAR;
        PG8_WAIT_V(4); PG8_BAR;
        PG8_STAGE(PG8_SB(1, 0), cB + kstep, voffB); PG8_STAGE(PG8_SA(1, 0), cA + kstep, voffA); PG8_STAGE(PG8_SB(1, 1), cB + hstep + kstep, voffB);
        PG8_WAIT_V(6); PG8_BAR;
    }
    for (;;) {
        const bool has_next = S.next(ui + 1, nxt);
        const char* nA = has_next ? (const char*)g.A + (size_t)nxt.pm * tstep : cA; const char* nB = has_next ? (const char*)g.Bt + (size_t)nxt.pn * tstep : cB;
        for (int t = 0; t < nt; t += 2) {
            const bool last = (t == nt - 2);
            const char* a1 = cA + (size_t)(t + 1) * kstep;
            const char* a2 = last ? nA : cA + (size_t)(t + 2) * kstep; const char* b2 = last ? nB : cB + (size_t)(t + 2) * kstep;
            const char* a3 = a2 + kstep; const char* b3 = b2 + kstep;
            if (last && has_next) S.a_ready(nxt);
            if constexpr (SP2) {
            PG8_LDB(B0, 0, 0); PG8_LDB(B1, 0, 1); PG8_SCHED; PG8_LDA(At, 0, 0); PG8_STAGE(PG8_SA(1, 1), a1 + hstep, voffA);
            PG8_WAIT_V(8); PG8_WAIT_L(0); PG8_BAR; PG8_MMA(0, 0, At, B0); PG8_MMA(0, 1, At, B1); PG8_BAR; PG8_SCHED;
            PG8_LDA(At, 0, 1); PG8_STAGE(PG8_SB(0, 0), b2, voffB); PG8_STAGE(PG8_SB(0, 1), b2 + hstep, voffB); PG8_STAGE(PG8_SA(0, 0), a2, voffA);
            PG8_WAIT_V(8); PG8_WAIT_L(0); PG8_BAR; PG8_MMA(1, 0, At, B0); PG8_MMA(1, 1, At, B1); PG8_BAR; PG8_SCHED;
            PG8_LDB(B0, 1, 0); PG8_LDB(B1, 1, 1); PG8_SCHED; PG8_LDA(At, 1, 0); PG8_STAGE(PG8_SA(0, 1), a2 + hstep, voffA);
            PG8_WAIT_V(8); PG8_WAIT_L(0); PG8_BAR; PG8_MMA(0, 0, At, B0); PG8_MMA(0, 1, At, B1); PG8_BAR; PG8_SCHED;
            PG8_LDA(At, 1, 1); PG8_STAGE(PG8_SB(1, 0), b3, voffB); PG8_STAGE(PG8_SB(1, 1), b3 + hstep, voffB); PG8_STAGE(PG8_SA(1, 0), a3, voffA);
            PG8_WAIT_V(8); PG8_WAIT_L(0); PG8_BAR; PG8_MMA(1, 0, At, B0); PG8_MMA(1, 1, At, B1); PG8_BAR; PG8_SCHED;
            } else {
            PG8_LDB(B0, 0, 0); PG8_SCHED; PG8_LDA(At, 0, 0); PG8_STAGE(PG8_SA(1, 1), a1 + hstep, voffA);
            PG8_WAIT_L(8); PG8_BAR; PG8_WAIT_L(0); PG8_MMA(0, 0, At, B0); PG8_BAR; PG8_SCHED;
            PG8_LDB(B1, 0, 1); PG8_STAGE(PG8_SB(0, 0), b2, voffB);
            PG8_BAR; PG8_WAIT_L(0); PG8_MMA(0, 1, At, B1); PG8_BAR;
            PG8_LDA(At, 0, 1); PG8_STAGE(PG8_SA(0, 0), a2, voffA);
            PG8_BAR; PG8_WAIT_L(0); PG8_MMA(1, 0, At, B0); PG8_BAR; PG8_SCHED;
            PG8_STAGE(PG8_SB(0, 1), b2 + hstep, voffB);
            PG8_WAIT_V(6); PG8_BAR; PG8_MMA(1, 1, At, B1); PG8_BAR;
            PG8_LDB(B0, 1, 0); PG8_SCHED; PG8_LDA(At, 1, 0); PG8_STAGE(PG8_SA(0, 1), a2 + hstep, voffA);
            PG8_WAIT_L(8); PG8_BAR; PG8_WAIT_L(0); PG8_MMA(0, 0, At, B0); PG8_BAR; PG8_SCHED;
            PG8_LDB(B1, 1, 1); PG8_STAGE(PG8_SB(1, 0), b3, voffB);
            PG8_BAR; PG8_WAIT_L(0); PG8_MMA(0, 1, At, B1); PG8_BAR;
            PG8_LDA(At, 1, 1); PG8_STAGE(PG8_SA(1, 0), a3, voffA);
            PG8_BAR; PG8_WAIT_L(0); PG8_MMA(1, 0, At, B0); PG8_BAR; PG8_SCHED;
            PG8_STAGE(PG8_SB(1, 1), b3 + hstep, voffB);
            PG8_WAIT_V(6); PG8_BAR; PG8_MMA(1, 1, At, B1); PG8_BAR;
            }
        }
        if constexpr (ALIGN_EPI) { if (wr == 0) PG8_BAR; }
        if constexpr (!Epi::AFTER_DRAIN) { E(acc, cur, wr, wc, fr, fq); S.done(cur); }
        if (!has_next) break;
#pragma unroll
        for (int a = 0; a < 2; ++a)
#pragma unroll
            for (int b = 0; b < 2; ++b)
#pragma unroll
                for (int m = 0; m < 4; ++m)
#pragma unroll
                    for (int n = 0; n < 2; ++n) acc[a][b][m][n] = (f32x4){0.f, 0.f, 0.f, 0.f};
        cur = nxt; cA = nA; cB = nB; ++ui;
        if constexpr (ALIGN_EPI) { if (wr == 1) PG8_BAR; }
    }
    PG8_WAIT_V(0);
    if constexpr (!ALIGN_EPI) { if (wr == 0) PG8_BAR; }
    PG8_BAR;
    if constexpr (Epi::AFTER_DRAIN) { E.fused(acc, cur, wr, wc, fr, fq, lds, wid, lane); S.done(cur); }
#undef PG8_SA
#undef PG8_SB
#undef PG8_STAGE
#undef PG8_LDA
#undef PG8_LDB
#undef PG8_MMA
#undef PG8_WAIT_V
#undef PG8_WAIT_L
#undef PG8_BAR
#undef PG8_SCHED
}
}

constexpr int DM = 1024, NB_P = 2, SEQ = 16384, DEPTH = 2, NB_S = 8, SEQ_S = 64, PAST = 4096, FF = 4096;
constexpr int MP = NB_P * SEQ, MS = NB_S * SEQ_S, MT = MP + MS;
constexpr int NIN = 3088, NZ = 3072;
constexpr int ZQ = 0, ZK = 256, ZV = 512, ZR = 1024, ZSQ = 1536, ZSK = 1792, ZSV = 2048, ZCB = 2304, ZCC = 2560, ZCH = 2816;
constexpr float LN_EPS = 1e-5f;
constexpr float ALPHA = 1.41421356237309515f;
constexpr int NWAVES = 8, NTHR = 512;
constexpr size_t O_Y = 0, O_KP = 34078720, O_VP = 50855936, O_GP = 67633152, O_CP = 67764224, O_KS = 67766272, O_VS = 68028416, O_GS = 68290560, O_CS = 68814848, O_END = 68823040;
constexpr size_t MiB = 1u << 20;
constexpr size_t WS_W = 1 * MiB;
constexpr size_t W_LAYER = (size_t)NZ * DM * 2 + (size_t)DM * DM * 2 + (size_t)FF * DM * 2 * 2;
constexpr size_t WOFF_OUT = (size_t)NZ * DM * 2, WOFF_UP = WOFF_OUT + (size_t)DM * DM * 2, WOFF_DOWN = WOFF_UP + (size_t)FF * DM * 2;
constexpr size_t WS_X = 50 * MiB;
constexpr size_t WS_Z = 115 * MiB;
constexpr size_t WS_MIX = WS_Z + (size_t)MT * NZ * 2;
constexpr size_t WS_H = WS_Z;
constexpr size_t WS_U = 392 * MiB;
constexpr int NGT = 8 * 256 + 32;
constexpr size_t WS_S = WS_U + (size_t)NGT * 8192 * 4;
constexpr size_t WS_D = WS_S + (size_t)NGT * 8192 * 2;
constexpr size_t WS_GLOW = WS_D + (size_t)NGT * 64 * 4;
constexpr size_t WS_END = WS_GLOW + (size_t)MT * 16 * 4;
static_assert(WS_W + 2 * W_LAYER <= WS_X && WS_X + (size_t)MT * DM * 2 <= WS_Z && WS_MIX + (size_t)MT * DM * 2 <= WS_U && WS_H + (size_t)MT * FF * 2 <= WS_U && WS_END <= 512 * MiB, "ws map");
constexpr int LDS_BYTES = 147456;

#define LAS __attribute__((address_space(3)))
typedef unsigned short bf16;
typedef float f32x4 __attribute__((ext_vector_type(4)));
typedef short bf16x8 __attribute__((ext_vector_type(8)));
typedef short bf16x4 __attribute__((ext_vector_type(4)));
typedef unsigned u32x4 __attribute__((ext_vector_type(4)));
typedef unsigned u32x2 __attribute__((ext_vector_type(2)));
using pg8::cvt_pk_bf16; using pg8::bf_lo; using pg8::bf_hi;
__device__ __forceinline__ bf16 f2bf(float f) { return (bf16)(cvt_pk_bf16(f, 0.f) & 0xffffu); }
__device__ __forceinline__ float bf2f(bf16 b) { return __builtin_bit_cast(float, (unsigned)b << 16); }
constexpr float LOG2E = 1.4426950408889634f, LN2 = 0.6931471805599453f;
__device__ __forceinline__ float fexp(float x) { return __builtin_amdgcn_exp2f(x * LOG2E); }
__device__ __forceinline__ float softplus(float z) { const float e = __builtin_amdgcn_exp2f(-__builtin_fabsf(z) * LOG2E); return __builtin_fmaxf(z, 0.f) + LN2 * __builtin_amdgcn_logf(1.f + e); }
__device__ __forceinline__ f32x4 mfma16(bf16x8 a, bf16x8 b, f32x4 c) { return __builtin_amdgcn_mfma_f32_16x16x32_bf16(a, b, c, 0, 0, 0); }
__device__ __forceinline__ int otid() { int t = threadIdx.x; asm volatile("" : "+v"(t)); return t; }
__device__ __forceinline__ float wave_sum(float v) {
#pragma unroll
    for (int o = 1; o < 64; o <<= 1) v += __shfl_xor(v, o);
    return v;
}

struct Args {
    const float* xp; const float* xs; const float* ck; const float* cv; const float* sg; const float* sc;
    const float* ln_in_g; const float* ln_in_b; const float* w_in; const float* w_gate_up; const float* b_gate; const float* gla_norm_g; const float* conv_w; const float* w_out;
    const float* ln1_g; const float* ln1_b; const float* w_up; const float* w_down; const float* ln2_g; const float* ln2_b;
    float* out; unsigned char* ws;
};
typedef const __attribute__((address_space(4))) Args* CArgs;
__device__ __forceinline__ CArgs get_args() { CArgs p = (CArgs)__builtin_amdgcn_kernarg_segment_ptr(); asm volatile("" : "+s"(p)); return p; }

__device__ __forceinline__ void p0_transpose_item(const float* W, int ldw, int K, bf16* WT, int n0, int src0, int nvalid, int k0, LAS float* scr, int lane) {
    const int c = lane & 31; const bool ok = c < nvalid;
#pragma unroll 8
    for (int i = 0; i < 32; ++i) { const int kk = 2 * i + (lane >> 5); scr[kk * 33 + c] = ok ? W[(size_t)(k0 + kk) * ldw + src0 + c] : 0.f; }
    asm volatile("s_waitcnt lgkmcnt(0)" ::: "memory");
    const int c8 = lane & 7;
#pragma unroll
    for (int j = 0; j < 4; ++j) { const int n = (lane >> 3) + 8 * j; const LAS float* s = scr + (8 * c8) * 33 + n;
        u32x4 o; o.x = cvt_pk_bf16(s[0 * 33], s[1 * 33]); o.y = cvt_pk_bf16(s[2 * 33], s[3 * 33]); o.z = cvt_pk_bf16(s[4 * 33], s[5 * 33]); o.w = cvt_pk_bf16(s[6 * 33], s[7 * 33]);
        *(u32x4*)(WT + (size_t)(n0 + n) * K + k0 + 8 * c8) = o; }
    asm volatile("s_waitcnt lgkmcnt(0)" ::: "memory");
}
__device__ __forceinline__ void ln_row(const float* xrow, const float* g, const float* b, bf16* outb, float* outf, float* glow, const LAS float* Wl, int lane) {
    const f32x4* xr = (const f32x4*)xrow + lane;
    f32x4 v[4]; float s = 0.f;
#pragma unroll
    for (int j = 0; j < 4; ++j) { v[j] = xr[64 * j]; s += (v[j].x + v[j].y) + (v[j].z + v[j].w); }
    const float mean = wave_sum(s) * (1.f / DM); float s2 = 0.f;
#pragma unroll
    for (int j = 0; j < 4; ++j) { v[j] = v[j] - mean; s2 += (v[j].x * v[j].x + v[j].y * v[j].y) + (v[j].z * v[j].z + v[j].w * v[j].w); }
    const float rstd = 1.f / sqrtf(wave_sum(s2) * (1.f / DM) + LN_EPS);
#pragma unroll
    for (int j = 0; j < 4; ++j) { const f32x4 gg = ((const f32x4*)g)[lane + 64 * j], bb = ((const f32x4*)b)[lane + 64 * j]; const f32x4 o = v[j] * rstd * gg + bb; v[j] = o;
        if (outb) { u32x2 w; w.x = cvt_pk_bf16(o.x, o.y); w.y = cvt_pk_bf16(o.z, o.w); ((u32x2*)outb)[lane + 64 * j] = w; }
        if (outf) ((f32x4*)outf)[lane + 64 * j] = o; }
    if (glow) {
        float p[16];
#pragma unroll
        for (int jj = 0; jj < 16; ++jj) { float a = 0.f;
#pragma unroll
            for (int j = 0; j < 4; ++j) { const f32x4 w = *(const LAS f32x4*)(Wl + jj * 1024 + 256 * j + 4 * lane); a += (v[j].x * w.x + v[j].y * w.y) + (v[j].z * w.z + v[j].w * w.w); }
            p[jj] = a; }
#pragma unroll
        for (int st = 0; st < 4; ++st) { const int n2 = 8 >> st, bit = 32 >> st; const bool hi = (lane & bit) != 0;
#pragma unroll
            for (int i = 0; i < 8; ++i) if (i < n2) { const float a = p[i], c = p[i + n2]; const float keep = hi ? c : a, send = hi ? a : c; p[i] = keep + __shfl_xor(send, bit); } }
        float r0 = p[0]; r0 += __shfl_xor(r0, 2); r0 += __shfl_xor(r0, 1);
        if ((lane & 3) == 0) glow[((lane >> 5) & 1) * 8 + ((lane >> 4) & 1) * 4 + ((lane >> 3) & 1) * 2 + ((lane >> 2) & 1)] = r0;
    }
}
__device__ __forceinline__ void stage_wglow(const float* w_in_l, LAS float* Wl, int tid) {
    for (int e = tid; e < 16384; e += NTHR) { const int k = e >> 4, jj = e & 15; Wl[jj * 1024 + k] = w_in_l[(size_t)k * NIN + 1536 + jj]; }
}

__device__ __forceinline__ void p0_prologue(CArgs A, LAS unsigned char* lds, int gw, int ngw, int wave, int lane) {
    LAS float* scr = (LAS float*)(lds + wave * 16384);
    constexpr int I_IN = 16 * (NZ / 32), I_OUT = 16 * 32, I_UP = 16 * (FF / 32), I_DOWN = (FF / 64) * 32, I_L = I_IN + I_OUT + I_UP + I_DOWN;
    for (int it = gw; it < 2 * I_L; it += ngw) {
        const int l = it / I_L; int r = it % I_L; unsigned char* wb = A->ws + WS_W + (size_t)l * W_LAYER;
        if (r < I_IN) { const int nblk = NZ / 32, kb = r / nblk, nb = r % nblk, n0 = 32 * nb; int src0, nv;
            if (n0 < 1536) { src0 = n0; nv = 32; } else { src0 = n0 + 16; nv = 32; }
            p0_transpose_item(A->w_in + (size_t)l * DM * NIN, NIN, DM, (bf16*)wb, n0, src0, nv, 64 * kb, scr, lane); continue; }
        r -= I_IN;
        if (r < I_OUT) { const int kb = r / 32, nb = r % 32; p0_transpose_item(A->w_out + (size_t)l * DM * DM, DM, DM, (bf16*)(wb + WOFF_OUT), 32 * nb, 32 * nb, 32, 64 * kb, scr, lane); continue; }
        r -= I_OUT;
        if (r < I_UP) { const int kb = r / 128, nb = r % 128; p0_transpose_item(A->w_up + (size_t)l * DM * FF, FF, DM, (bf16*)(wb + WOFF_UP), 32 * nb, 32 * nb, 32, 64 * kb, scr, lane); continue; }
        r -= I_UP;
        { const int kb = r / 32, nb = r % 32; p0_transpose_item(A->w_down + (size_t)l * FF * DM, DM, FF, (bf16*)(wb + WOFF_DOWN), 32 * nb, 32 * nb, 32, 64 * kb, scr, lane); }
    }
    bf16* X = (bf16*)(A->ws + WS_X); float* GL = (float*)(A->ws + WS_GLOW); LAS float* Wl = (LAS float*)lds;
    __syncthreads(); stage_wglow(A->w_in, Wl, wave * 64 + lane); __syncthreads();
    for (int m = gw; m < MT; m += ngw) { const float* src = (m < MP) ? A->xp + (size_t)m * DM : A->xs + (size_t)(m - MP) * DM; ln_row(src, A->ln_in_g, A->ln_in_b, X + (size_t)m * DM, nullptr, GL + (size_t)m * 16, Wl, lane); }
}

constexpr int SB_KS = 72, SB_VS = 136;
constexpr int SB_OFF_K = 0, SB_OFF_V = 128 * SB_KS * 2, SB_OFF_F = SB_OFF_V + 64 * SB_VS * 2;
__device__ __forceinline__ bf16x8 cvt8(const float* p) { const f32x4 a = *(const f32x4*)p, b = *(const f32x4*)(p + 4); u32x4 w; w.x = cvt_pk_bf16(a.x, a.y); w.y = cvt_pk_bf16(a.z, a.w); w.z = cvt_pk_bf16(b.x, b.y); w.w = cvt_pk_bf16(b.z, b.w); return __builtin_bit_cast(bf16x8, w); }
__device__ __forceinline__ void sb_attn_unit(LAS unsigned char* lds, const bf16* Z, const float* cacheK, const float* cacheV, bf16* MIX, int sample, int b, int h, int qb) {
    const int tid = otid(), lane = tid & 63, wave = __builtin_amdgcn_readfirstlane(tid >> 6), r = lane & 15, quad = lane >> 4;
    LAS bf16* Ks = (LAS bf16*)(lds + SB_OFF_K); LAS bf16* Vt = (LAS bf16*)(lds + SB_OFF_V); volatile LAS unsigned* flags = (volatile LAS unsigned*)(lds + SB_OFF_F);
    const int nq = sample ? 64 : 128;
    const size_t rowbase = sample ? (size_t)(MP + b * 64) : (size_t)b * SEQ + (size_t)qb * 128;
    const int qpos0 = sample ? PAST : qb * 128, kb_diag = sample ? 32 : qb;
    const bool wactive = wave * 16 < nq;
    bf16x8 qf[2];
    { const bf16* qp = Z + (rowbase + (wactive ? wave * 16 + r : 0)) * NZ + ZSQ + h * 64 + quad * 8; qf[0] = *(const bf16x8*)qp; qf[1] = *(const bf16x8*)(qp + 32); }
    const int tq = qpos0 + wave * 16 + r;
    float carry = 0.f;
    f32x4 oacc[4];
#pragma unroll
    for (int i = 0; i < 4; ++i) oacc[i] = (f32x4){0.f, 0.f, 0.f, 0.f};
    for (int kb = kb_diag; kb >= 0; --kb) {
#pragma unroll
        for (int i = 0; i < 2; ++i) {
            const int ch = tid + i * 512, key = ch >> 3, c8 = (ch & 7) * 8;
            bf16x8 kv, vv;
            if (!sample) { const bf16* p = Z + ((size_t)b * SEQ + (size_t)kb * 128 + key) * NZ + h * 64 + c8; kv = *(const bf16x8*)(p + ZSK); vv = *(const bf16x8*)(p + ZSV); }
            else if (kb < 32) { const size_t o = (((size_t)b * PAST + (size_t)kb * 128 + key) * 4 + h) * 64 + c8; kv = cvt8(cacheK + o); vv = cvt8(cacheV + o); }
            else if (key < 64) { const bf16* p = Z + ((size_t)MP + b * 64 + key) * NZ + h * 64 + c8; kv = *(const bf16x8*)(p + ZSK); vv = *(const bf16x8*)(p + ZSV); }
            else { kv = (bf16x8){0, 0, 0, 0, 0, 0, 0, 0}; vv = kv; }
            *(LAS bf16x8*)(Ks + key * SB_KS + c8) = kv;
#pragma unroll
            for (int e = 0; e < 8; ++e) Vt[(c8 + e) * SB_VS + key] = (bf16)vv[e];
        }
        __syncthreads();
        bool done = true;
        if (wactive) {
            f32x4 z[8], xl[8];
#pragma unroll
            for (int kt = 0; kt < 8; ++kt) { z[kt] = (f32x4){0.f, 0.f, 0.f, 0.f};
#pragma unroll
                for (int ks = 0; ks < 2; ++ks) { const bf16x8 a = *(const LAS bf16x8*)(Ks + (16 * kt + r) * SB_KS + ks * 32 + quad * 8); z[kt] = mfma16(a, qf[ks], z[kt]); } }
            const bool diag = (kb == kb_diag);
            float G[8], T[8];
#pragma unroll
            for (int kt = 0; kt < 8; ++kt) {
                float g = 0.f;
#pragma unroll
                for (int j = 0; j < 4; ++j) { const float zz = z[kt][j] * 0.125f; const int kabs = kb * 128 + 16 * kt + 4 * quad + j; const bool valid = !diag || (kabs < tq);
                    const float sp = softplus(zz); xl[kt][j] = valid ? -sp : 0.f; z[kt][j] = valid ? (zz - sp) : -1e30f; g += xl[kt][j]; }
                const float b_ = __shfl_xor(g, 16), c_ = __shfl_xor(g, 32), d_ = __shfl_xor(g, 48);
                T[kt] = (g + b_) + (c_ + d_);
                G[kt] = quad == 0 ? (b_ + c_ + d_) : quad == 1 ? (c_ + d_) : quad == 2 ? b_ : 0.f;
            }
            float after = carry; unsigned pk[8][2];
#pragma unroll
            for (int kt = 7; kt >= 0; --kt) {
                const float a3 = after + G[kt], a2 = a3 + xl[kt][3], a1 = a2 + xl[kt][2], a0 = a1 + xl[kt][1];
                const float p0 = fexp(z[kt][0] + a0), p1 = fexp(z[kt][1] + a1), p2 = fexp(z[kt][2] + a2), p3 = fexp(z[kt][3] + a3);
                pk[kt][0] = cvt_pk_bf16(p0, p1); pk[kt][1] = cvt_pk_bf16(p2, p3);
                after += T[kt];
            }
            carry = after;
#pragma unroll
            for (int i = 0; i < 4; ++i) {
                u32x4 pw; pw.x = pk[2 * i][0]; pw.y = pk[2 * i][1]; pw.z = pk[2 * i + 1][0]; pw.w = pk[2 * i + 1][1];
                const bf16x8 pb = __builtin_bit_cast(bf16x8, pw);
#pragma unroll
                for (int dt = 0; dt < 4; ++dt) {
                    const LAS bf16* vp = Vt + (16 * dt + r) * SB_VS + 32 * i + 4 * quad;
                    const u32x2 lo = *(const LAS u32x2*)vp, hi = *(const LAS u32x2*)(vp + 16);
                    u32x4 vw; vw.x = lo.x; vw.y = lo.y; vw.z = hi.x; vw.w = hi.y;
                    oacc[dt] = mfma16(__builtin_bit_cast(bf16x8, vw), pb, oacc[dt]);
                }
            }
            done = __all(carry < -104.f);
        }
        if (lane == 0) flags[wave] = done ? 1u : 0u;
        __syncthreads();
        unsigned alld = 1u;
#pragma unroll
        for (int w = 0; w < 8; ++w) alld &= flags[w];
        if (alld) break;
    }
    if (wactive) {
        bf16* op = MIX + (rowbase + wave * 16 + r) * DM + 512 + h * 64 + 4 * quad;
#pragma unroll
        for (int dt = 0; dt < 4; ++dt) { u32x2 w; w.x = cvt_pk_bf16(oacc[dt][0], oacc[dt][1]); w.y = cvt_pk_bf16(oacc[dt][2], oacc[dt][3]); *(u32x2*)(op + 16 * dt) = w; }
    }
    __syncthreads();
}

constexpr int GS = 72;
constexpr int G_OFF_B = 0, G_OFF_PART = 16384, G_OFF_QS = 18432, G_OFF_KS = 27648, G_OFF_KLT = 36864, G_OFF_VT = 46080, G_OFF_ATT = 64512, G_OFF_ST = 73728, G_OFF_WG = 92160, G_OFF_SSQ = 96256, G_OFF_GLW = 96768;
__device__ __forceinline__ void gla_unit(LAS unsigned char* lds, const int mode, const bf16* Z, const float* GL, const float* Wg, const float* bg, const float* gnorm, float* U, bf16* Sb, float* Dd, bf16* MIX, size_t rowbase, int h, int gt) {
    const int tid = otid(), lane = tid & 63, wave = __builtin_amdgcn_readfirstlane(tid >> 6), r = lane & 15, quad = lane >> 4;
    LAS float* bsm = (LAS float*)(lds + G_OFF_B); LAS float* part = (LAS float*)(lds + G_OFF_PART);
    LAS bf16* qs = (LAS bf16*)(lds + G_OFF_QS); LAS bf16* ks = (LAS bf16*)(lds + G_OFF_KS); LAS bf16* klT = (LAS bf16*)(lds + G_OFF_KLT);
    LAS bf16* Vt = (LAS bf16*)(lds + G_OFF_VT); LAS bf16* att = (LAS bf16*)(lds + G_OFF_ATT); LAS bf16* St = (LAS bf16*)(lds + G_OFF_ST);
    LAS float* wg = (LAS float*)(lds + G_OFF_WG); LAS float* ssq = (LAS float*)(lds + G_OFF_SSQ); LAS float* glw = (LAS float*)(lds + G_OFF_GLW);
#pragma unroll
    for (int i = 0; i < 2; ++i) { const int e = tid + i * 512; wg[e] = Wg[(e >> 6) * 256 + h * 64 + (e & 63)]; glw[e] = GL[rowbase * 16 + e]; }
#pragma unroll
    for (int i = 0; i < 2; ++i) { const int ch = tid + i * 512, s = ch >> 4, c8 = (ch & 15) * 8; const bf16x8 vv = *(const bf16x8*)(Z + (rowbase + s) * NZ + ZV + h * 128 + c8);
#pragma unroll
        for (int e = 0; e < 8; ++e) Vt[(c8 + e) * GS + s] = (bf16)vv[e]; }
    if (mode == 1) {
#pragma unroll
        for (int i = 0; i < 2; ++i) { const int ch = tid + i * 512, v = ch >> 3, c8 = (ch & 7) * 8; *(LAS bf16x8*)(St + v * GS + c8) = *(const bf16x8*)(Sb + (size_t)gt * 8192 + v * 64 + c8); }
    }
    __syncthreads();
    { const int k = lane, seg = wave; float loc[8]; float run = 0.f; const float bias = bg[h * 64 + k];
#pragma unroll
        for (int tt = 0; tt < 8; ++tt) { const int t = seg * 8 + tt; float pre = bias;
#pragma unroll
            for (int i = 0; i < 16; ++i) pre += glw[t * 16 + i] * wg[i * 64 + k];
            const float lg = -softplus(-pre) * (1.f / 16.f); run += lg; loc[tt] = run; }
        part[seg * 64 + k] = run;
        __syncthreads();
        float pre = 0.f;
#pragma unroll
        for (int s2 = 0; s2 < 8; ++s2) pre += (s2 < seg) ? part[s2 * 64 + k] : 0.f;
#pragma unroll
        for (int tt = 0; tt < 8; ++tt) bsm[(seg * 8 + tt) * 64 + k] = pre + loc[tt];
    }
    __syncthreads();
    { const int t = tid >> 3, c8 = (tid & 7) * 8; const bf16* zp = Z + (rowbase + t) * NZ + h * 64 + c8;
        const bf16x8 k8 = *(const bf16x8*)(zp + ZK);
        if (mode == 1) { const bf16x8 q8 = *(const bf16x8*)(zp + ZQ); float qv[8], kv[8];
#pragma unroll
            for (int e = 0; e < 8; ++e) { const float bb = bsm[t * 64 + c8 + e]; qv[e] = bf2f((bf16)q8[e]) * 0.125f * fexp(bb); kv[e] = bf2f((bf16)k8[e]) * fexp(-bb); }
            u32x4 w; w.x = cvt_pk_bf16(qv[0], qv[1]); w.y = cvt_pk_bf16(qv[2], qv[3]); w.z = cvt_pk_bf16(qv[4], qv[5]); w.w = cvt_pk_bf16(qv[6], qv[7]); *(LAS u32x4*)(qs + t * GS + c8) = w;
            w.x = cvt_pk_bf16(kv[0], kv[1]); w.y = cvt_pk_bf16(kv[2], kv[3]); w.z = cvt_pk_bf16(kv[4], kv[5]); w.w = cvt_pk_bf16(kv[6], kv[7]); *(LAS u32x4*)(ks + t * GS + c8) = w;
        } else {
#pragma unroll
            for (int e = 0; e < 8; ++e) { const float bb = bsm[t * 64 + c8 + e], bl = bsm[63 * 64 + c8 + e]; klT[(c8 + e) * GS + t] = f2bf(bf2f((bf16)k8[e]) * fexp(bl - bb)); }
            if (tid < 64) Dd[(size_t)gt * 64 + tid] = fexp(bsm[63 * 64 + tid]);
        }
    }
    __syncthreads();
    if (mode == 0) {
#pragma unroll
        for (int nt = 0; nt < 4; ++nt) { f32x4 c = (f32x4){0.f, 0.f, 0.f, 0.f};
#pragma unroll
            for (int k0 = 0; k0 < 2; ++k0) { const bf16x8 a = *(const LAS bf16x8*)(Vt + (16 * wave + r) * GS + k0 * 32 + quad * 8), bq = *(const LAS bf16x8*)(klT + (16 * nt + r) * GS + k0 * 32 + quad * 8); c = mfma16(a, bq, c); }
#pragma unroll
            for (int j = 0; j < 4; ++j) U[(size_t)gt * 8192 + (16 * wave + 4 * quad + j) * 64 + 16 * nt + r] = c[j]; }
    } else {
        { const int mt = wave >> 1;
#pragma unroll
            for (int n2 = 0; n2 < 2; ++n2) { const int nt = (wave & 1) * 2 + n2; f32x4 c = (f32x4){0.f, 0.f, 0.f, 0.f};
#pragma unroll
                for (int k0 = 0; k0 < 2; ++k0) { const bf16x8 a = *(const LAS bf16x8*)(qs + (16 * mt + r) * GS + k0 * 32 + quad * 8), bq = *(const LAS bf16x8*)(ks + (16 * nt + r) * GS + k0 * 32 + quad * 8); c = mfma16(a, bq, c); }
#pragma unroll
                for (int j = 0; j < 4; ++j) { const int t = 16 * mt + 4 * quad + j, s = 16 * nt + r; att[t * GS + s] = f2bf(s <= t ? c[j] : 0.f); } } }
        __syncthreads();
        const int mt = wave >> 1; f32x4 o[4]; float sq[4] = {0.f, 0.f, 0.f, 0.f};
#pragma unroll
        for (int n4 = 0; n4 < 4; ++n4) { const int nt = (wave & 1) * 4 + n4; f32x4 c = (f32x4){0.f, 0.f, 0.f, 0.f};
#pragma unroll
            for (int k0 = 0; k0 < 2; ++k0) { const bf16x8 a = *(const LAS bf16x8*)(att + (16 * mt + r) * GS + k0 * 32 + quad * 8), bq = *(const LAS bf16x8*)(Vt + (16 * nt + r) * GS + k0 * 32 + quad * 8); c = mfma16(a, bq, c); }
#pragma unroll
            for (int k0 = 0; k0 < 2; ++k0) { const bf16x8 a = *(const LAS bf16x8*)(qs + (16 * mt + r) * GS + k0 * 32 + quad * 8), bq = *(const LAS bf16x8*)(St + (16 * nt + r) * GS + k0 * 32 + quad * 8); c = mfma16(a, bq, c); }
            o[n4] = c;
#pragma unroll
            for (int j = 0; j < 4; ++j) sq[j] += c[j] * c[j]; }
#pragma unroll
        for (int j = 0; j < 4; ++j) { float v = sq[j]; v += __shfl_xor(v, 1); v += __shfl_xor(v, 2); v += __shfl_xor(v, 4); v += __shfl_xor(v, 8); sq[j] = v; }
        if (r == 0) {
#pragma unroll
            for (int j = 0; j < 4; ++j) ssq[(16 * mt + 4 * quad + j) * 2 + (wave & 1)] = sq[j]; }
        __syncthreads();
#pragma unroll
        for (int j = 0; j < 4; ++j) { const int t = 16 * mt + 4 * quad + j; const float rstd = 1.f / sqrtf((ssq[t * 2] + ssq[t * 2 + 1]) * (1.f / 128.f) + LN_EPS);
#pragma unroll
            for (int n4 = 0; n4 < 4; ++n4) { const int v = 16 * ((wave & 1) * 4 + n4) + r; const float gr = bf2f(Z[(rowbase + t) * NZ + ZR + h * 128 + v]);
                const float on = o[n4][j] * rstd;
                const float val = on * gnorm[h * 128 + v] * (gr / (1.f + fexp(-gr)));
                MIX[(rowbase + t) * DM + h * 128 + v] = f2bf(val); } }
    }
    __syncthreads();
}

__device__ __forceinline__ void gla_scan(CArgs A, int l, int bx, int G, int tid) {
    const float* __restrict__ U = (const float*)(A->ws + WS_U); bf16* __restrict__ Sb = (bf16*)(A->ws + WS_S); const float* __restrict__ Dd = (const float*)(A->ws + WS_D);
    float* __restrict__ out = A->out;
    if (tid < 256) {
        for (int it = bx * 256 + tid; it < 65536; it += G * 256) {
            const int seq = it >> 13, e = it & 8191, k = e & 63, v = e >> 6; float S = 0.f;
            const float* up = U + (size_t)seq * 256 * 8192 + e; const float* dp = Dd + (size_t)seq * 256 * 64 + k; bf16* sp = Sb + (size_t)seq * 256 * 8192 + e;
            float u[16], d[16];
#pragma unroll
            for (int i = 0; i < 16; ++i) { u[i] = up[(size_t)i * 8192]; d[i] = dp[i * 64]; }
            for (int c0 = 0; c0 < 256; c0 += 16) {
                float un[16], dn[16];
                if (c0 + 16 < 256) {
#pragma unroll
                    for (int i = 0; i < 16; ++i) { un[i] = up[(size_t)(c0 + 16 + i) * 8192]; dn[i] = dp[(c0 + 16 + i) * 64]; }
                }
#pragma unroll
                for (int i = 0; i < 16; ++i) { sp[(size_t)(c0 + i) * 8192] = f2bf(S); S = d[i] * S + u[i]; }
#pragma unroll
                for (int i = 0; i < 16; ++i) { u[i] = un[i]; d[i] = dn[i]; }
            }
            out[O_GP + (size_t)l * 65536 + (size_t)seq * 8192 + k * 128 + v] = S;
        }
    } else {
        const float* __restrict__ sg = A->sg;
        for (int p = bx * 256 + (tid - 256); p < 32 * 8192; p += G * 256) {
            const int sq = p >> 13, e = p & 8191, k = e & 63, v = e >> 6; const size_t gt = 2048 + sq;
            const float S0 = sg[(size_t)l * 262144 + (size_t)sq * 8192 + k * 128 + v];
            Sb[gt * 8192 + e] = f2bf(S0);
            out[O_GS + (size_t)l * 262144 + (size_t)sq * 8192 + k * 128 + v] = Dd[gt * 64 + k] * S0 + U[gt * 8192 + e]; }
    }
}

__device__ __forceinline__ void conv_phase(CArgs A, int l, int gtid, int nthreads) {
    const bf16* Z = (const bf16*)(A->ws + WS_Z); bf16* MIX = (bf16*)(A->ws + WS_MIX); const float* cw = A->conv_w + (size_t)l * 3 * 256;
    for (int it = gtid; it < MT * 32; it += nthreads) {
        const int row = it >> 5, c8 = (it & 31) * 8; int t, b, sample;
        if (row < MP) { sample = 0; b = row >> 14; t = row & (SEQ - 1); } else { sample = 1; b = (row - MP) >> 6; t = (row - MP) & 63; }
        const bf16* zp = Z + (size_t)row * NZ + c8;
        const u32x4 cb = *(const u32x4*)(zp + ZCB), cc0 = *(const u32x4*)(zp + ZCC), ch0 = *(const u32x4*)(zp + ZCH);
        float u0[8], u1[8], u2[8], cbf[8];
        { const unsigned* c = (const unsigned*)&cc0; const unsigned* hh = (const unsigned*)&ch0; const unsigned* bb = (const unsigned*)&cb;
#pragma unroll
          for (int e = 0; e < 4; ++e) { u0[2 * e] = bf_lo(c[e]) * bf_lo(hh[e]); u0[2 * e + 1] = bf_hi(c[e]) * bf_hi(hh[e]); cbf[2 * e] = bf_lo(bb[e]); cbf[2 * e + 1] = bf_hi(bb[e]); } }
#pragma unroll
        for (int d = 1; d <= 2; ++d) { float* ud = (d == 1) ? u1 : u2;
            if (t - d >= 0) { const bf16* zq = zp - (size_t)d * NZ; const u32x4 c1 = *(const u32x4*)(zq + ZCC), h1 = *(const u32x4*)(zq + ZCH); const unsigned* c = (const unsigned*)&c1; const unsigned* hh = (const unsigned*)&h1;
#pragma unroll
                for (int e = 0; e < 4; ++e) { ud[2 * e] = bf_lo(c[e]) * bf_lo(hh[e]); ud[2 * e + 1] = bf_hi(c[e]) * bf_hi(hh[e]); } }
            else if (sample) { const float* pv = A->sc + (((size_t)l * NB_S + b) * 2 + (2 + t - d)) * 256 + c8;
#pragma unroll
                for (int e = 0; e < 8; ++e) ud[e] = pv[e]; }
            else {
#pragma unroll
                for (int e = 0; e < 8; ++e) ud[e] = 0.f; } }
        float y[8];
#pragma unroll
        for (int e = 0; e < 8; ++e) y[e] = cbf[e] * (cw[512 + c8 + e] * u0[e] + cw[256 + c8 + e] * u1[e] + cw[c8 + e] * u2[e]);
        u32x4 w; w.x = cvt_pk_bf16(y[0], y[1]); w.y = cvt_pk_bf16(y[2], y[3]); w.z = cvt_pk_bf16(y[4], y[5]); w.w = cvt_pk_bf16(y[6], y[7]);
        *(u32x4*)(MIX + (size_t)row * DM + 768 + c8) = w;
        const int T = sample ? SEQ_S : SEQ;
        if (t >= T - 2) { float* o = sample ? A->out + O_CS + (((size_t)l * NB_S + b) * 2 + (t - (T - 2))) * 256 + c8 : A->out + O_CP + (((size_t)l * NB_P + b) * 2 + (t - (T - 2))) * 256 + c8;
#pragma unroll
            for (int e = 0; e < 8; ++e) o[e] = u0[e]; }
    }
}

template <int TM, int TN, int KS, class Epi>
__device__ __forceinline__ void small_gemm(LAS unsigned char* lds, const bf16* __restrict__ Am, const bf16* __restrict__ Bt, const int N, const int K, const Epi& E) {
    constexpr int WM = TM / 32, WN = TN / 32; static_assert(WM * WN * KS == 8, "8 waves");
    const int tid = otid(), lane = tid & 63, wave = __builtin_amdgcn_readfirstlane(tid >> 6), r = lane & 15, quad = lane >> 4;
    const int wk = wave / (WM * WN), wmn = wave % (WM * WN), wm = wmn / WN, wn = wmn % WN;
    const int ntn = N / TN, ntiles = (MS / TM) * ntn, kper = K / KS, G = gridDim.x;
    LAS f32x4* red = (LAS f32x4*)lds;
    for (int t = blockIdx.x; t < ntiles; t += G) {
        const int tm = t / ntn, tn = t % ntn, row0 = tm * TM + wm * 32, col0 = tn * TN + wn * 32;
        f32x4 acc[2][2];
#pragma unroll
        for (int a = 0; a < 2; ++a)
#pragma unroll
            for (int c = 0; c < 2; ++c) acc[a][c] = (f32x4){0.f, 0.f, 0.f, 0.f};
        const bf16* ap = Am + (size_t)(row0 + r) * K + wk * kper + quad * 8;
        const bf16* bp = Bt + (size_t)(col0 + r) * K + wk * kper + quad * 8;
        for (int k0 = 0; k0 < kper; k0 += 128) {
            bf16x8 af[4][2], bq[4][2];
#pragma unroll
            for (int s = 0; s < 4; ++s)
#pragma unroll
                for (int i = 0; i < 2; ++i) { af[s][i] = *(const bf16x8*)(ap + (size_t)i * 16 * K + k0 + s * 32); bq[s][i] = *(const bf16x8*)(bp + (size_t)i * 16 * K + k0 + s * 32); }
#pragma unroll
            for (int s = 0; s < 4; ++s)
#pragma unroll
                for (int mi = 0; mi < 2; ++mi)
#pragma unroll
                    for (int ni = 0; ni < 2; ++ni) acc[mi][ni] = mfma16(bq[s][ni], af[s][mi], acc[mi][ni]);
        }
        if (KS > 1) {
            if (wk > 0) {
#pragma unroll
                for (int mi = 0; mi < 2; ++mi)
#pragma unroll
                    for (int ni = 0; ni < 2; ++ni) red[(((wk - 1) * (WM * WN) + wmn) * 4 + mi * 2 + ni) * 64 + lane] = acc[mi][ni];
            }
            __syncthreads();
            if (wk == 0) {
#pragma unroll
                for (int k2 = 1; k2 < KS; ++k2)
#pragma unroll
                    for (int mi = 0; mi < 2; ++mi)
#pragma unroll
                        for (int ni = 0; ni < 2; ++ni) acc[mi][ni] += red[(((k2 - 1) * (WM * WN) + wmn) * 4 + mi * 2 + ni) * 64 + lane];
            }
        }
        if (wk == 0) E(acc, row0, col0, r, quad);
        if (KS > 1) __syncthreads();
    }
}
struct SEpiZ { bf16* Z; float* ks; float* vs;
    __device__ __forceinline__ void operator()(const f32x4 (&acc)[2][2], int row0, int col0, int r, int quad) const {
#pragma unroll
        for (int mi = 0; mi < 2; ++mi)
#pragma unroll
            for (int ni = 0; ni < 2; ++ni) { const int row = row0 + 16 * mi + r, col = col0 + 16 * ni + 4 * quad; const f32x4 v = acc[mi][ni];
                u32x2 w; w.x = cvt_pk_bf16(v[0], v[1]); w.y = cvt_pk_bf16(v[2], v[3]); *(u32x2*)(Z + (size_t)(MP + row) * NZ + col) = w;
                if (col >= ZSK && col < ZSK + 256) *(f32x4*)(ks + (size_t)row * 256 + (col - ZSK)) = v;
                if (col >= ZSV && col < ZSV + 256) *(f32x4*)(vs + (size_t)row * 256 + (col - ZSV)) = v; }
    }
};
struct SEpiT { const bf16* X; float* T;
    __device__ __forceinline__ void operator()(const f32x4 (&acc)[2][2], int row0, int col0, int r, int quad) const {
#pragma unroll
        for (int mi = 0; mi < 2; ++mi)
#pragma unroll
            for (int ni = 0; ni < 2; ++ni) { const size_t off = (size_t)(MP + row0 + 16 * mi + r) * DM + col0 + 16 * ni + 4 * quad; const u32x2 xw = *(const u32x2*)(X + off); f32x4 v = acc[mi][ni];
                v[0] += ALPHA * bf_lo(xw.x); v[1] += ALPHA * bf_hi(xw.x); v[2] += ALPHA * bf_lo(xw.y); v[3] += ALPHA * bf_hi(xw.y); *(f32x4*)(T + off) = v; }
    }
};
struct SEpiH { bf16* H;
    __device__ __forceinline__ void operator()(const f32x4 (&acc)[2][2], int row0, int col0, int r, int quad) const {
#pragma unroll
        for (int mi = 0; mi < 2; ++mi)
#pragma unroll
            for (int ni = 0; ni < 2; ++ni) { f32x4 v = acc[mi][ni];
#pragma unroll
                for (int e = 0; e < 4; ++e) { const float a = v[e] > 0.f ? v[e] : 0.f; v[e] = a * a; }
                u32x2 w; w.x = cvt_pk_bf16(v[0], v[1]); w.y = cvt_pk_bf16(v[2], v[3]); *(u32x2*)(H + (size_t)(MP + row0 + 16 * mi + r) * FF + col0 + 16 * ni + 4 * quad) = w; }
    }
};

#define GAS __attribute__((address_space(1)))
#define XB_TMO      128
#define XB_XCNT(j)  (256  + 64 * (j))
#define XB_XSUB(j)  (1280 + 64 * (j))
#define XB_XGEN(j)  (2304 + 64 * (j))
#define XB_TOP      3328
#define XB_TOPGEN   3392
#define XCD_BAR_WORDS 3456
#define XB_SPIN_CAP (1u << 18)

__device__ __forceinline__ unsigned xb_ld(unsigned* p)              { return __hip_atomic_load(p, __ATOMIC_RELAXED, __HIP_MEMORY_SCOPE_AGENT); }
__device__ __forceinline__ unsigned xb_add(unsigned* p, unsigned v) { return __hip_atomic_fetch_add(p, v, __ATOMIC_RELAXED, __HIP_MEMORY_SCOPE_AGENT); }
__device__ __forceinline__ unsigned xb_xcc_id() { return (unsigned)__builtin_amdgcn_s_getreg((3 << 11) | 20) & 0xFu; }
#define XB_SPIN(cond, bar) do { unsigned _sp = 0; while (cond) { __builtin_amdgcn_s_sleep(1); \
    if ((++_sp & 255u) == 0u) { if (xb_ld(&(bar)[XB_TMO])) break; if (_sp > XB_SPIN_CAP) { atomicAdd(&(bar)[XB_TMO], 1u); break; } } } } while (0)

struct XcdBarrier {
    unsigned* bar; unsigned x;
    volatile LAS unsigned* st;
};

__device__ __forceinline__ XcdBarrier xcd_barrier_post(unsigned* bar, volatile LAS unsigned* st) {
    XcdBarrier b; b.bar = bar; b.x = xb_xcc_id(); b.st = st;
    if (threadIdx.x == 0) (void)xb_add(&bar[XB_XCNT(b.x)], 1u);
    return b;
}
__device__ __forceinline__ void xcd_barrier_complete(unsigned* bar, unsigned x, unsigned& nloc, unsigned& nx) {
    const unsigned G = gridDim.x * gridDim.y * gridDim.z;
    unsigned sum, cnt, mine, sp = 0u;
    for (;;) {
        sum = 0u; cnt = 0u; mine = 0u;
#pragma unroll
        for (unsigned j = 0; j < 16; ++j) { const unsigned c = xb_ld(&bar[XB_XCNT(j)]); sum += c; cnt += (c > 0u) ? 1u : 0u; mine = (j == x) ? c : mine; }
        if (sum == G) break;
        __builtin_amdgcn_s_sleep(1);
        if ((++sp & 255u) == 0u) { if (xb_ld(&bar[XB_TMO])) break; if (sp > XB_SPIN_CAP) { atomicAdd(&bar[XB_TMO], 1u); break; } }
    }
    nloc = mine > 0u ? mine : 1u; nx = cnt > 0u ? cnt : 1u;
}

__device__ __forceinline__ void xcd_barrier(const XcdBarrier& b) {
    asm volatile("s_waitcnt vmcnt(0)" ::: "memory");
    __syncthreads();
    if (threadIdx.x == 0) {
        unsigned* bar = b.bar;
        __builtin_amdgcn_s_waitcnt(0);
        unsigned nloc = b.st[0], nx = b.st[1];
        if (nloc == 0u) { xcd_barrier_complete(bar, b.x, nloc, nx); b.st[0] = nloc; b.st[1] = nx; }
        const unsigned old = xb_add(&bar[XB_XSUB(b.x)], 1u);
        const unsigned gen = old / nloc;
        if (old + 1u == (gen + 1u) * nloc) {
            __builtin_amdgcn_fence(__ATOMIC_RELEASE, "agent");
            asm volatile("s_waitcnt vmcnt(0)" ::: "memory");
            const unsigned og = xb_add(&bar[XB_TOP], 1u);
            const unsigned tg = og / nx;
            if (og + 1u == (tg + 1u) * nx) xb_add(&bar[XB_TOPGEN], 1u);
            else XB_SPIN(xb_ld(&bar[XB_TOPGEN]) == tg, bar);
            __builtin_amdgcn_fence(__ATOMIC_ACQUIRE, "agent");
            xb_add(&bar[XB_XGEN(b.x)], 1u);
            asm volatile("s_waitcnt vmcnt(0)" ::: "memory");
        } else {
            XB_SPIN(xb_ld(&bar[XB_XGEN(b.x)]) == gen, bar);
            __builtin_amdgcn_fence(__ATOMIC_ACQUIRE, "agent");
            asm volatile("s_waitcnt vmcnt(0)" ::: "memory");
        }
    }
    __syncthreads();
}

__device__ __forceinline__ void phase_gemm_in(LAS unsigned char* lds, int l) {
    CArgs A = get_args(); const int G = gridDim.x, bx = blockIdx.x;
    pg8::Gemm g{(const bf16*)(A->ws + WS_X), (const bf16*)(A->ws + WS_W + (size_t)l * W_LAYER), MP, NZ, DM}; pg8::StaticOrder S; S.init(MP, NZ, G, bx);
    pg8::EpiZ E{(bf16*)(A->ws + WS_Z), A->out, l};
    pg8::gemm_phase<pg8::EpiZ, pg8::StaticOrder, true, true>(lds, g, S, E);
    SEpiZ SE{(bf16*)(A->ws + WS_Z), A->out + O_KS + (size_t)l * MS * 256, A->out + O_VS + (size_t)l * MS * 256};
    small_gemm<64, 128, 1, SEpiZ>(lds, g.A + (size_t)MP * DM, g.Bt, NZ, DM, SE);
}
__device__ __forceinline__ void phase_gemm_out(LAS unsigned char* lds, int l) {
    CArgs A = get_args(); const int G = gridDim.x, bx = blockIdx.x;
    pg8::Gemm g{(const bf16*)(A->ws + WS_MIX), (const bf16*)(A->ws + WS_W + (size_t)l * W_LAYER + WOFF_OUT), MP, DM, DM}; pg8::StaticOrder S; S.init(MP, DM, G, bx);
    pg8::EpiT E{(const bf16*)(A->ws + WS_X), A->out + O_Y};
    pg8::gemm_phase<pg8::EpiT, pg8::StaticOrder, true, true>(lds, g, S, E);
    SEpiT SE{E.X, E.T};
    small_gemm<32, 64, 4, SEpiT>(lds, g.A + (size_t)MP * DM, g.Bt, DM, DM, SE);
}
__device__ __forceinline__ void phase_gemm_up(LAS unsigned char* lds, int l) {
    CArgs A = get_args(); const int G = gridDim.x, bx = blockIdx.x;
    pg8::Gemm g{(const bf16*)(A->ws + WS_X), (const bf16*)(A->ws + WS_W + (size_t)l * W_LAYER + WOFF_UP), MP, FF, DM}; pg8::StaticOrder S; S.init(MP, FF, G, bx);
    pg8::EpiH E{(bf16*)(A->ws + WS_H)};
    pg8::gemm_phase<pg8::EpiH, pg8::StaticOrder, true, true>(lds, g, S, E);
    SEpiH SE{E.Hp};
    small_gemm<64, 128, 1, SEpiH>(lds, g.A + (size_t)MP * DM, g.Bt, FF, DM, SE);
}
__device__ __forceinline__ void phase_gemm_down(LAS unsigned char* lds, int l) {
    CArgs A = get_args(); const int G = gridDim.x, bx = blockIdx.x;
    pg8::Gemm g{(const bf16*)(A->ws + WS_H), (const bf16*)(A->ws + WS_W + (size_t)l * W_LAYER + WOFF_DOWN), MP, DM, FF}; pg8::StaticOrder S; S.init(MP, DM, G, bx);
    pg8::EpiT E{(const bf16*)(A->ws + WS_X), A->out + O_Y};
    pg8::gemm_phase<pg8::EpiT, pg8::StaticOrder, true, true>(lds, g, S, E);
    SEpiT SE{E.X, E.T};
    small_gemm<32, 64, 4, SEpiT>(lds, g.A + (size_t)MP * FF, g.Bt, DM, FF, SE);
}
__device__ __forceinline__ void gt_rows(int gt, size_t& rowbase, int& h) {
    if (gt < 2048) { const int bh = gt >> 8, c = gt & 255; h = bh & 3; rowbase = (size_t)(bh >> 2) * SEQ + (size_t)c * 64; } else { const int s = gt - 2048; h = s & 3; rowbase = (size_t)MP + (size_t)(s >> 2) * 64; }
}
__device__ __forceinline__ void phase_mix_local(LAS unsigned char* lds, int l) {
    CArgs A = get_args(); const int G = gridDim.x, bx = blockIdx.x;
    const bf16* Z = (const bf16*)(A->ws + WS_Z); bf16* MIX = (bf16*)(A->ws + WS_MIX);
    const float* ck = A->ck + (size_t)l * NB_S * PAST * 256; const float* cv = A->cv + (size_t)l * NB_S * PAST * 256;
    constexpr int NSB = 1024 + 32;
    for (int u = bx; u < NSB; u += G) {
        if (u < 1024) { const int qb = 127 - (u >> 3), bh = u & 7; sb_attn_unit(lds, Z, ck, cv, MIX, 0, bh >> 2, bh & 3, qb); }
        else { const int s = u - 1024; sb_attn_unit(lds, Z, ck, cv, MIX, 1, s >> 2, s & 3, 0); }
    }
    const float* Wg = A->w_gate_up + (size_t)l * 16 * 256; const float* bg = A->b_gate + (size_t)l * 256; const float* gn = A->gla_norm_g + (size_t)l * 512;
    float* U = (float*)(A->ws + WS_U); bf16* Sb = (bf16*)(A->ws + WS_S); float* Dd = (float*)(A->ws + WS_D); const float* GL = (const float*)(A->ws + WS_GLOW);
    for (int gt = bx; gt < NGT; gt += G) { size_t rowbase; int h; gt_rows(gt, rowbase, h); gla_unit(lds, 0, Z, GL, Wg, bg, gn, U, Sb, Dd, MIX, rowbase, h, gt); }
    conv_phase(A, l, bx * NTHR + otid(), G * NTHR);
}
__device__ __forceinline__ void phase_gla_out(LAS unsigned char* lds, int l) {
    CArgs A = get_args(); const int G = gridDim.x, bx = blockIdx.x;
    const bf16* Z = (const bf16*)(A->ws + WS_Z); bf16* MIX = (bf16*)(A->ws + WS_MIX);
    const float* Wg = A->w_gate_up + (size_t)l * 16 * 256; const float* bg = A->b_gate + (size_t)l * 256; const float* gn = A->gla_norm_g + (size_t)l * 512;
    float* U = (float*)(A->ws + WS_U); bf16* Sb = (bf16*)(A->ws + WS_S); float* Dd = (float*)(A->ws + WS_D); const float* GL = (const float*)(A->ws + WS_GLOW);
    for (int gt = bx; gt < NGT; gt += G) { size_t rowbase; int h; gt_rows(gt, rowbase, h); gla_unit(lds, 1, Z, GL, Wg, bg, gn, U, Sb, Dd, MIX, rowbase, h, gt); }
}
__device__ __forceinline__ void phase_ln(LAS unsigned char* lds, int l, int which) {
    CArgs A = get_args(); const int tid = otid(); const int G = gridDim.x, bx = blockIdx.x, lane = tid & 63, wave = tid >> 6;
    const int gw = bx * NWAVES + wave, ngw = G * NWAVES;
    float* T = A->out + O_Y; bf16* X = (bf16*)(A->ws + WS_X); float* GL = (float*)(A->ws + WS_GLOW); LAS float* Wl = (LAS float*)lds;
    const float* g = (which ? A->ln2_g : A->ln1_g) + (size_t)l * DM; const float* b = (which ? A->ln2_b : A->ln1_b) + (size_t)l * DM;
    const bool last = which && (l == DEPTH - 1), wantg = which && !last;
    if (wantg) { stage_wglow(A->w_in + (size_t)(l + 1) * DM * NIN, Wl, tid); __syncthreads(); }
    for (int m = gw; m < MT; m += ngw) ln_row(T + (size_t)m * DM, g, b, last ? nullptr : X + (size_t)m * DM, last ? T + (size_t)m * DM : nullptr, wantg ? GL + (size_t)m * 16 : nullptr, Wl, lane);
}

constexpr int MISC_OFF = 131072 + 320;
__global__ void __launch_bounds__(NTHR, 2) hymba_fwd(Args Aunused) {
    extern __shared__ __attribute__((aligned(16))) unsigned char lds_raw[];
    LAS unsigned char* lds = (LAS unsigned char*)lds_raw;
    cg::grid_group grid = cg::this_grid();
    volatile LAS unsigned* MISC = (volatile LAS unsigned*)(lds + MISC_OFF);
    unsigned* barw;
    { CArgs A = get_args(); unsigned* ctl = (unsigned*)A->ws; barw = ctl + 4096;
      if (threadIdx.x < 32) MISC[threadIdx.x] = 0u;
      if (blockIdx.x == 0) for (int i = threadIdx.x; i < 8192; i += NTHR) __hip_atomic_store(ctl + i, 0u, __ATOMIC_RELAXED, __HIP_MEMORY_SCOPE_AGENT); }
    __syncthreads();
    grid.sync();
    XcdBarrier bar = xcd_barrier_post(barw, MISC + 8);
#define GSYNC() xcd_barrier(bar)
    { CArgs A = get_args(); const int tid = otid(), wave = tid >> 6; p0_prologue(A, lds, blockIdx.x * NWAVES + wave, gridDim.x * NWAVES, wave, tid & 63); }
    GSYNC();
    for (int l = 0; l < DEPTH; ++l) {
        phase_gemm_in(lds, l);      GSYNC();
        phase_mix_local(lds, l);    GSYNC();
        { CArgs A = get_args(); gla_scan(A, l, blockIdx.x, gridDim.x, otid()); }
        GSYNC();
        phase_gla_out(lds, l);      GSYNC();
        phase_gemm_out(lds, l);     GSYNC();
        phase_ln(lds, l, 0);        GSYNC();
        phase_gemm_up(lds, l);      GSYNC();
        phase_gemm_down(lds, l);    GSYNC();
        phase_ln(lds, l, 1);
        if (l + 1 < DEPTH) GSYNC();
    }
}

extern "C" void kernel_launch(void* const* d_in, const int* in_sizes, int n_in, void* d_out, int out_size, void* d_ws, size_t ws_size, hipStream_t stream) {
    static int grid = 0;
    if (grid == 0) {
        int dev = 0, cus = 0, per_cu = 0;
        hipGetDevice(&dev); hipDeviceGetAttribute(&cus, hipDeviceAttributeMultiprocessorCount, dev);
        hipFuncSetAttribute((const void*)hymba_fwd, hipFuncAttributeMaxDynamicSharedMemorySize, LDS_BYTES);
        if (hipOccupancyMaxActiveBlocksPerMultiprocessor(&per_cu, (const void*)hymba_fwd, NTHR, LDS_BYTES) != hipSuccess || per_cu < 1) { (void)hipGetLastError(); per_cu = 1; }
        grid = cus * per_cu;
        if (ws_size < WS_END || n_in != 20 || (size_t)out_size != O_END) fprintf(stderr, "kernel_launch: unexpected sizes ws %zu n_in %d out %d\n", ws_size, n_in, out_size);
    }
    Args a{};
    a.xp = (const float*)d_in[0]; a.xs = (const float*)d_in[1]; a.ck = (const float*)d_in[2]; a.cv = (const float*)d_in[3]; a.sg = (const float*)d_in[4]; a.sc = (const float*)d_in[5];
    a.ln_in_g = (const float*)d_in[6]; a.ln_in_b = (const float*)d_in[7]; a.w_in = (const float*)d_in[8]; a.w_gate_up = (const float*)d_in[9]; a.b_gate = (const float*)d_in[10];
    a.gla_norm_g = (const float*)d_in[11]; a.conv_w = (const float*)d_in[12]; a.w_out = (const float*)d_in[13]; a.ln1_g = (const float*)d_in[14]; a.ln1_b = (const float*)d_in[15];
    a.w_up = (const float*)d_in[16]; a.w_down = (const float*)d_in[17]; a.ln2_g = (const float*)d_in[18]; a.ln2_b = (const float*)d_in[19];
    a.out = (float*)d_out; a.ws = (unsigned char*)d_ws;
    void* args[] = {&a};
    hipError_t e = hipLaunchCooperativeKernel((const void*)hymba_fwd, dim3(grid), dim3(NTHR), args, LDS_BYTES, stream);
    if (e != hipSuccess) fprintf(stderr, "cooperative launch failed: %s (grid %d)\n", hipGetErrorString(e), grid);
}
```
